# Optimizing an MI355X kernel written in HIP

```python
import math
import jax, jax.numpy as jnp
from jax import lax
import numpy as np

D_MODEL = 1024
BATCH = 4
SEQ = 4096
DEPTH = 1

MEM_LEN = 256
RWKV_HEAD_DIM = 64
RWKV_WIDTH = D_MODEL // 2
RWKV_HEADS = RWKV_WIDTH // RWKV_HEAD_DIM
DECAY_LORA = 64
ICLR_LORA = 64
GATE_LORA = 160
RWKV_IN = 3 * RWKV_WIDTH + DECAY_LORA + ICLR_LORA + GATE_LORA
RWKV_GN_EPS = 64e-5
DIFF_HEAD_DIM = 64
DIFF_WIDTH = D_MODEL - RWKV_WIDTH
DIFF_HEADS = DIFF_WIDTH // (2 * DIFF_HEAD_DIM)
DIFF_IN = 3 * DIFF_WIDTH
MIX_IN = RWKV_IN + DIFF_IN
Q_BLOCK = 128
CROSS_HEADS = 4
CROSS_HEAD_DIM = D_MODEL // CROSS_HEADS
N_EXPERTS = 32
TOP_K = 4
D_FF_EXPERT = D_MODEL
SWIGLU_LIMIT = 7.0
SWIGLU_ALPHA = 1.702
MOE_BLOCK = 128
NORM_EPS = 1e-5

kernel_name = 'hymba_rwkv7_diffattn_moe_layer'


def rms_norm(x, g, eps=NORM_EPS):
    xf = x.astype(jnp.float32)
    y = xf * lax.rsqrt(jnp.mean(xf * xf, axis=-1, keepdims=True) + eps)
    return (y * g.astype(jnp.float32)).astype(x.dtype)


def token_shift(y, mu):
    y_prev = jnp.pad(y, ((0, 0), (1, 0), (0, 0)))[:, :-1]
    return y + mu * (y_prev - y)


def alibi_slopes(n):
    return jnp.exp2(-8.0 * jnp.arange(1, n + 1, dtype=jnp.float32) / n)


def diff_lambda_init(layer):
    return 0.8 - 0.6 * math.exp(-0.3 * layer)


def rwkv7_group(u, w0, w_decay_up, a0, w_iclr_up, w_gate_up, k_k, k_a, r_k, lnx_g, lnx_b):
    f32 = jnp.float32
    B, S, _ = u.shape
    H, N, C = RWKV_HEADS, RWKV_HEAD_DIM, RWKV_WIDTH
    r, k, v, xw, xa, xg = jnp.split(
        u, [C, 2 * C, 3 * C, 3 * C + DECAY_LORA, 3 * C + DECAY_LORA + ICLR_LORA], axis=-1)
    w_log = -jax.nn.softplus(-(w0 + jnp.tanh(xw) @ w_decay_up)) - 0.5
    decay = jnp.exp(-jnp.exp(w_log.astype(f32)))
    a = jax.nn.sigmoid(a0 + xa @ w_iclr_up)
    g = jax.nn.sigmoid(xg) @ w_gate_up
    heads = lambda t: t.reshape(B, S, H, N)
    kk = heads(k * k_k).astype(f32)
    kk = kk / jnp.maximum(jnp.linalg.norm(kk, axis=-1, keepdims=True), 1e-12)
    k = k * (1.0 + (a - 1.0) * k_a)
    r_h, k_h, v_h, a_h = heads(r), heads(k), heads(v), heads(a)
    seq_first = lambda t: jnp.moveaxis(t.astype(f32), 1, 0)

    def step(state, inp):
        r_t, w_t, k_t, v_t, kk_t, a_t = inp
        sa = jnp.einsum('bhvk,bhk->bhv', state, -kk_t)
        state = (state * w_t[:, :, None, :]
                 + sa[..., None] * (kk_t * a_t)[:, :, None, :]
                 + v_t[..., None] * k_t[:, :, None, :])
        return state, jnp.einsum('bhvk,bhk->bhv', state, r_t)

    state0 = jnp.zeros((B, H, N, N), f32)
    scan_in = (seq_first(r_h), seq_first(heads(decay)), seq_first(k_h),
               seq_first(v_h), seq_first(kk), seq_first(a_h))
    _, y = lax.scan(step, state0, scan_in)
    y = jnp.moveaxis(y, 0, 1)
    mu = jnp.mean(y, axis=-1, keepdims=True)
    var = jnp.mean(jnp.square(y - mu), axis=-1, keepdims=True)
    y = ((y - mu) * lax.rsqrt(var + RWKV_GN_EPS)).reshape(B, S, C)
    y = y * lnx_g.astype(f32) + lnx_b.astype(f32)
    bonus = jnp.sum((r_h * k_h * r_k).astype(f32), axis=-1, keepdims=True) * v_h.astype(f32)
    y = (y + bonus.reshape(B, S, C)) * g.astype(f32)
    return y.astype(u.dtype)


def diff_attention_group(u, lambda_q1, lambda_k1, lambda_q2, lambda_k2, subln_g, lambda_init):
    f32 = jnp.float32
    B, S, _ = u.shape
    H, d = DIFF_HEADS, DIFF_HEAD_DIM
    q, k, v = jnp.split(u, 3, axis=-1)
    q = q.reshape(B, S, H, 2, d) * (d ** -0.5)
    k = k.reshape(B, S, H, 2, d)
    v = v.reshape(B, S, H, 2 * d)
    lam = (jnp.exp(jnp.sum(lambda_q1 * lambda_k1).astype(f32))
           - jnp.exp(jnp.sum(lambda_q2 * lambda_k2).astype(f32)) + lambda_init)
    slopes = alibi_slopes(H)
    n_blocks = S // Q_BLOCK
    q_blocks = jnp.moveaxis(q.reshape(B, n_blocks, Q_BLOCK, H, 2, d), 1, 0)
    key_pos = jnp.arange(S)

    def block(args):
        qb, bi = args
        q_pos = bi * Q_BLOCK + jnp.arange(Q_BLOCK)
        dist = (q_pos[:, None] - key_pos[None, :]).astype(f32)
        bias = jnp.where(dist[None] >= 0, -slopes[:, None, None] * dist[None], -jnp.inf)
        s = jnp.einsum('bqhcd,bkhcd->bhcqk', qb, k).astype(f32) + bias[None, :, None]
        p = jax.nn.softmax(s, axis=-1)
        attn = p[:, :, 0] - lam * p[:, :, 1]
        return jnp.einsum('bhqk,bkhe->bqhe', attn.astype(v.dtype), v)

    o = lax.map(block, (q_blocks, jnp.arange(n_blocks)))
    o = jnp.moveaxis(o, 0, 1).reshape(B, S, H, 2 * d)
    o = rms_norm(o, subln_g) * (1.0 - lambda_init)
    return o.reshape(B, S, DIFF_WIDTH)


def cross_attention(h, m, w_cq, w_ckv, w_co):
    B, S, D = h.shape
    M = m.shape[1]
    q = (h @ w_cq).reshape(B, S, CROSS_HEADS, CROSS_HEAD_DIM)
    k, v = jnp.split(m @ w_ckv, 2, axis=-1)
    k = k.reshape(B, M, CROSS_HEADS, CROSS_HEAD_DIM)
    v = v.reshape(B, M, CROSS_HEADS, CROSS_HEAD_DIM)
    s = jnp.einsum('bqhd,bkhd->bhqk', q, k).astype(jnp.float32) * (CROSS_HEAD_DIM ** -0.5)
    p = jax.nn.softmax(s, axis=-1).astype(v.dtype)
    o = jnp.einsum('bhqk,bkhd->bqhd', p, v).reshape(B, S, D)
    return o @ w_co


def clamped_swiglu(hid):
    x_glu = jnp.minimum(hid[..., ::2], SWIGLU_LIMIT)
    x_lin = jnp.clip(hid[..., 1::2], -SWIGLU_LIMIT, SWIGLU_LIMIT)
    return x_glu * jax.nn.sigmoid(SWIGLU_ALPHA * x_glu) * (x_lin + 1.0)


def moe_ffn(h, w_router, b_router, w1, b1, w2, b2):
    B, S, D = h.shape
    T = B * S
    n_assign = T * TOP_K
    n_blocks = n_assign // MOE_BLOCK + N_EXPERTS
    n_rows = n_blocks * MOE_BLOCK
    xt = h.reshape(T, D)
    logits = (xt @ w_router + b_router).astype(jnp.float32)
    top_vals, top_idx = lax.top_k(logits, TOP_K)
    gates = jax.nn.softmax(top_vals, axis=-1)
    flat_e = top_idx.reshape(-1)
    flat_tok = jnp.repeat(jnp.arange(T, dtype=jnp.int32), TOP_K)
    flat_gate = gates.reshape(-1)
    order = jnp.argsort(flat_e)
    sorted_e = flat_e[order]
    counts = jnp.bincount(flat_e, length=N_EXPERTS)
    padded = (counts + MOE_BLOCK - 1) // MOE_BLOCK * MOE_BLOCK
    start = jnp.cumsum(counts) - counts
    pad_end = jnp.cumsum(padded)
    pad_start = pad_end - padded
    dest = pad_start[sorted_e] + jnp.arange(n_assign, dtype=jnp.int32) - start[sorted_e]
    row_tok = jnp.full((n_rows,), T, jnp.int32).at[dest].set(flat_tok[order])
    row_gate = jnp.zeros((n_rows,), jnp.float32).at[dest].set(flat_gate[order])
    block_e = jnp.minimum(
        jnp.searchsorted(pad_end, jnp.arange(n_blocks, dtype=jnp.int32) * MOE_BLOCK, side='right'),
        N_EXPERTS - 1)
    x_pad = jnp.concatenate([xt, jnp.zeros((1, D), xt.dtype)], axis=0)

    def expert_block(args):
        tok, e = args
        hid = x_pad[tok] @ w1[e] + b1[e]
        return clamped_swiglu(hid) @ w2[e] + b2[e]

    y = lax.map(expert_block, (row_tok.reshape(n_blocks, MOE_BLOCK), block_e))
    y = y.reshape(n_rows, D) * row_gate[:, None].astype(y.dtype)
    out = jax.ops.segment_sum(y, row_tok, num_segments=T + 1)[:T]
    return out.reshape(B, S, D)


def setup_inputs(seed: int = 0) -> dict:
    key = jax.random.key(seed)
    ks = iter(jax.random.split(key, 48))
    f32 = jnp.float32
    L, D, E, F = DEPTH, D_MODEL, N_EXPERTS, D_FF_EXPERT
    C, d = RWKV_WIDTH, DIFF_HEAD_DIM

    def normal(shape, scale):
        return scale * jax.random.normal(next(ks), shape, f32)

    def gain(shape):
        return 1.0 + 0.02 * jax.random.normal(next(ks), shape, f32)

    def uniform(shape, lo, hi):
        return jax.random.uniform(next(ks), shape, f32, lo, hi)

    return {
        'x': normal((BATCH, SEQ, D), 1.0),
        'mem': normal((BATCH, MEM_LEN, D), 1.0),
        'norm_mix_g': gain((L, D)),
        'w_in': normal((L, D, MIX_IN), D ** -0.5),
        'shift_mu': uniform((L, RWKV_IN), 0.0, 1.0),
        'w0': uniform((L, C), -4.0, 1.0),
        'w_decay_up': normal((L, DECAY_LORA, C), 0.5 * DECAY_LORA ** -0.5),
        'a0': normal((L, C), 0.1),
        'w_iclr_up': normal((L, ICLR_LORA, C), ICLR_LORA ** -0.5),
        'w_gate_up': normal((L, GATE_LORA, C), GATE_LORA ** -0.5),
        'k_k': 0.85 + normal((L, C), 0.02),
        'k_a': gain((L, C)),
        'r_k': normal((L, RWKV_HEADS, RWKV_HEAD_DIM), 0.1),
        'lnx_g': gain((L, C)),
        'lnx_b': normal((L, C), 0.01),
        'lambda_q1': normal((L, d), 0.1),
        'lambda_k1': normal((L, d), 0.1),
        'lambda_q2': normal((L, d), 0.1),
        'lambda_k2': normal((L, d), 0.1),
        'subln_g': gain((L, 2 * d)),
        'w_out': normal((L, D, D), D ** -0.5),
        'norm_cross_g': gain((L, D)),
        'norm_mem_g': gain((L, D)),
        'w_cq': normal((L, D, D), D ** -0.5),
        'w_ckv': normal((L, D, 2 * D), D ** -0.5),
        'w_co': normal((L, D, D), D ** -0.5),
        'norm_ffn_g': gain((L, D)),
        'w_router': normal((L, D, E), D ** -0.5),
        'b_router': normal((L, E), 0.01),
        'w1': normal((L, E, D, 2 * F), D ** -0.5),
        'b1': normal((L, E, 2 * F), 0.01),
        'w2': normal((L, E, F, D), F ** -0.5),
        'b2': normal((L, E, D), 0.01),
        'norm_final_g': gain((D,)),
    }


def reference(x, mem, norm_mix_g, w_in, shift_mu, w0, w_decay_up, a0, w_iclr_up, w_gate_up,
              k_k, k_a, r_k, lnx_g, lnx_b, lambda_q1, lambda_k1, lambda_q2, lambda_k2, subln_g,
              w_out, norm_cross_g, norm_mem_g, w_cq, w_ckv, w_co, norm_ffn_g, w_router, b_router,
              w1, b1, w2, b2, norm_final_g):
    for l in range(DEPTH):
        h = rms_norm(x, norm_mix_g[l])
        proj = h @ w_in[l]
        u_rwkv = token_shift(proj[..., :RWKV_IN], shift_mu[l])
        u_diff = proj[..., RWKV_IN:]
        y_rwkv = rwkv7_group(u_rwkv, w0[l], w_decay_up[l], a0[l], w_iclr_up[l], w_gate_up[l],
                             k_k[l], k_a[l], r_k[l], lnx_g[l], lnx_b[l])
        y_diff = diff_attention_group(u_diff, lambda_q1[l], lambda_k1[l], lambda_q2[l],
                                      lambda_k2[l], subln_g[l], diff_lambda_init(l))
        x = x + jnp.concatenate([y_rwkv, y_diff], axis=-1) @ w_out[l]
        x = x + cross_attention(rms_norm(x, norm_cross_g[l]), rms_norm(mem, norm_mem_g[l]),
                                w_cq[l], w_ckv[l], w_co[l])
        x = x + moe_ffn(rms_norm(x, norm_ffn_g[l]), w_router[l], b_router[l],
                        w1[l], b1[l], w2[l], b2[l])
    return rms_norm(x, norm_final_g)
```

```cpp
#include <hip/hip_runtime.h>
#include <math.h>
#include <stdint.h>

constexpr int D = 1024, BATCH = 4, SEQ = 4096, T = BATCH * SEQ, MEM = 256;
constexpr int C = 512, NH = 8, HN = 64, RWKV_IN = 1824, MIX_IN = 3360;
constexpr int NE = 32, TOPK = 4, FF = 1024;
constexpr float NORM_EPS = 1e-5f, GN_EPS = 64e-5f;

struct ARows { const float* A; long lda; long sz1, sz2; int zdiv; int M;
  __device__ int rows(int) const { return M; }
  __device__ const float* ptr(int z, int m) const { return A + (long)(z / zdiv) * sz1 + (long)(z % zdiv) * sz2 + (long)m * lda; } };
struct AGather { const float* A; long lda; const int* list; const int* count; int cap; int div;
  __device__ int rows(int z) const { return count[z]; }
  __device__ const float* ptr(int z, int m) const { return A + (long)(list[(long)z * cap + m] / div) * lda; } };
template <bool TRANS> struct BMat { const float* B; long ldb; long sz1, sz2; long zdiv;
  __device__ float get(int z, int k, int n) const { const float* b = B + (long)(z / zdiv) * sz1 + (long)(z % zdiv) * sz2; return TRANS ? b[(long)n * ldb + k] : b[(long)k * ldb + n]; } };
struct EpiStore { float* Cc; long ldc; long sz1, sz2; long zdiv; const float* R; float alpha; int pad;
  __device__ void row4(int z, int m, int n, const float* a, int N) const {
    long off = (long)(z / zdiv) * sz1 + (long)(z % zdiv) * sz2 + (long)m * ldc;
    for (int j = 0; j < 4; ++j) if (n + j < N) { float v = alpha * a[j]; if (R) v += R[off + n + j]; Cc[off + n + j] = v; } } };
struct EpiSwiglu { float* act; const int* list; long cap; const float* b1;
  __device__ void row4(int z, int m, int n, const float* a, int N) const {
    int slot = list[(long)z * cap + m];
    for (int j = 0; j < 4; j += 2) { float g = a[j] + b1[(long)z * 2 * FF + n + j], l = a[j + 1] + b1[(long)z * 2 * FF + n + j + 1];
      g = fminf(g, 7.f); l = fminf(fmaxf(l, -7.f), 7.f);
      act[(long)slot * FF + (n + j) / 2] = g * (1.f / (1.f + expf(-1.702f * g))) * (l + 1.f); } } };
struct EpiMoeOut { float* ye; const int* list; long cap; const float* b2; const float* gate;
  __device__ void row4(int z, int m, int n, const float* a, int N) const {
    int slot = list[(long)z * cap + m]; float g = gate[slot];
    for (int j = 0; j < 4; ++j) ye[(long)slot * D + n + j] = (a[j] + b2[(long)z * D + n + j]) * g; } };

template <class AM, class BM, class EP>
__global__ __launch_bounds__(256) void gemm_naive(AM am, BM bm, EP ep, int N, int K) {
  __shared__ float As[16][68], Bs[16][68];
  const int z = blockIdx.z, m0 = blockIdx.y * 64, n0 = blockIdx.x * 64;
  const int Mz = am.rows(z);
  if (m0 >= Mz) return;
  const int tx = threadIdx.x & 15, ty = threadIdx.x >> 4;
  float acc[4][4];
  for (int i = 0; i < 4; ++i) for (int j = 0; j < 4; ++j) acc[i][j] = 0.f;
  for (int k0 = 0; k0 < K; k0 += 16) {
    for (int i = 0; i < 4; ++i) { int idx = threadIdx.x + i * 256; int r = idx >> 4, kk = idx & 15;
      As[kk][r] = (m0 + r < Mz) ? am.ptr(z, m0 + r)[k0 + kk] : 0.f; }
    for (int i = 0; i < 4; ++i) { int idx = threadIdx.x + i * 256; int kk = idx >> 6, c = idx & 63;
      Bs[kk][c] = (n0 + c < N) ? bm.get(z, k0 + kk, n0 + c) : 0.f; }
    __syncthreads();
#pragma unroll
    for (int kk = 0; kk < 16; ++kk) { float a[4], b[4];
      for (int i = 0; i < 4; ++i) a[i] = As[kk][ty * 4 + i];
      for (int j = 0; j < 4; ++j) b[j] = Bs[kk][tx * 4 + j];
      for (int i = 0; i < 4; ++i) for (int j = 0; j < 4; ++j) acc[i][j] += a[i] * b[j]; }
    __syncthreads();
  }
  for (int i = 0; i < 4; ++i) { int m = m0 + ty * 4 + i; if (m < Mz && n0 + tx * 4 < N) ep.row4(z, m, n0 + tx * 4, acc[i], N); }
}

__global__ __launch_bounds__(256) void rmsnorm_rows(const float* x, const float* g, float* out, int rows) {
  int row = blockIdx.x * 4 + (threadIdx.x >> 6), lane = threadIdx.x & 63;
  if (row >= rows) return;
  const float* xr = x + (long)row * D; float v[16]; float ss = 0.f;
  for (int i = 0; i < 16; ++i) { v[i] = xr[lane + 64 * i]; ss += v[i] * v[i]; }
  for (int o = 1; o < 64; o <<= 1) ss += __shfl_xor(ss, o);
  float rs = 1.0f / sqrtf(ss * (1.f / D) + NORM_EPS);
  for (int i = 0; i < 16; ++i) out[(long)row * D + lane + 64 * i] = v[i] * rs * g[lane + 64 * i];
}

__global__ __launch_bounds__(512) void rwkv_prep(const float* proj, const float* mu, const float* w0, const float* Wd, const float* a0, const float* Wa, const float* Wg,
                                                 const float* k_k, const float* k_a, float* R, float* W, float* K, float* V, float* KK, float* KKA, float* G) {
  __shared__ float su[RWKV_IN]; __shared__ float ssq[512];
  const int t = blockIdx.x, c = threadIdx.x; const bool first = (t % SEQ) == 0;
  const float* p = proj + (long)t * MIX_IN; const float* pp = p - MIX_IN;
  for (int j = c; j < RWKV_IN; j += 512) { float y = p[j], yp = first ? 0.f : pp[j]; float u = y + mu[j] * (yp - y);
    if (j >= 1536 && j < 1600) u = tanhf(u); else if (j >= 1664) u = 1.f / (1.f + expf(-u));
    su[j] = u; }
  __syncthreads();
  float dw = w0[c], da = a0[c], dg = 0.f;
#pragma unroll 4
  for (int i = 0; i < 64; ++i) { dw += su[1536 + i] * Wd[i * C + c]; da += su[1600 + i] * Wa[i * C + c]; }
#pragma unroll 4
  for (int i = 0; i < 160; ++i) dg += su[1664 + i] * Wg[i * C + c];
  float z = -dw; float sp = fmaxf(z, 0.f) + log1pf(expf(-fabsf(z)));
  float wlog = -sp - 0.5f; float decay = expf(-expf(wlog));
  float aa = 1.f / (1.f + expf(-da));
  float r = su[c], k = su[512 + c], v = su[1024 + c];
  float kkv = k * k_k[c]; ssq[c] = kkv * kkv; __syncthreads();
  float s2 = 0.f; int h0 = c & ~63;
#pragma unroll 8
  for (int i = 0; i < 64; ++i) s2 += ssq[h0 + i];
  float kk = kkv / fmaxf(sqrtf(s2), 1e-12f);
  float k2 = k * (1.f + (aa - 1.f) * k_a[c]);
  long o = (long)t * C + c;
  R[o] = r; W[o] = decay; K[o] = k2; V[o] = v; KK[o] = kk; KKA[o] = kk * aa; G[o] = dg;
}

#define RL(x, j) __int_as_float(__builtin_amdgcn_readlane(__float_as_int(x), (j)))
__global__ __launch_bounds__(64) void rwkv_scan(const float* R, const float* W, const float* K, const float* V, const float* KK, const float* KKA, const float* G,
                                                const float* r_k, const float* lnx_g, const float* lnx_b, float* Y) {
  const int b = blockIdx.x / NH, h = blockIdx.x % NH, lane = threadIdx.x; const int c = h * HN + lane;
  float s[64];
#pragma unroll
  for (int j = 0; j < 64; ++j) s[j] = 0.f;
  const float rk = r_k[c], lg = lnx_g[c], lb = lnx_b[c];
  for (int t = 0; t < SEQ; ++t) {
    long o = ((long)b * SEQ + t) * C + c;
    const float r = R[o], w = W[o], k = K[o], v = V[o], kk = KK[o], kka = KKA[o], g = G[o];
    float sa = 0.f;
#pragma unroll
    for (int j = 0; j < 64; ++j) sa -= s[j] * RL(kk, j);
    float y = 0.f;
#pragma unroll
    for (int j = 0; j < 64; ++j) { s[j] = s[j] * RL(w, j) + sa * RL(kka, j) + v * RL(k, j); y += s[j] * RL(r, j); }
    float mu = y; for (int q = 1; q < 64; q <<= 1) mu += __shfl_xor(mu, q); mu *= (1.f / 64.f);
    float d = y - mu, var = d * d; for (int q = 1; q < 64; q <<= 1) var += __shfl_xor(var, q); var *= (1.f / 64.f);
    float yn = d * (1.0f / sqrtf(var + GN_EPS)) * lg + lb;
    float bs = r * k * rk; for (int q = 1; q < 64; q <<= 1) bs += __shfl_xor(bs, q);
    Y[((long)b * SEQ + t) * D + c] = (yn + bs * v) * g;
  }
}

__global__ __launch_bounds__(256) void diff_attn_naive(const float* proj, float* OC) {
  const int qb = blockIdx.x, hc = blockIdx.y, b = blockIdx.z; const int h = hc >> 1, cm = hc & 1;
  const int q = qb * 256 + threadIdx.x;
  const float slope = exp2f(-2.0f * (h + 1));
  const float* base = proj + (long)b * SEQ * MIX_IN + RWKV_IN;
  const float* qp = base + (long)q * MIX_IN + h * 128 + cm * 64;
  float qr[64];
#pragma unroll
  for (int d = 0; d < 64; ++d) qr[d] = qp[d] * 0.125f;
  float o[128];
#pragma unroll
  for (int e = 0; e < 128; ++e) o[e] = 0.f;
  float m = -INFINITY, l = 0.f;
  const int jmax = qb * 256 + 255;
  for (int j = 0; j <= jmax; ++j) {
    const float* kp = base + (long)j * MIX_IN + 512 + h * 128 + cm * 64;
    const float* vp = base + (long)j * MIX_IN + 1024 + h * 128;
    if (j <= q) {
      float s = 0.f;
#pragma unroll
      for (int d = 0; d < 64; ++d) s += qr[d] * kp[d];
      s -= slope * (float)(q - j);
      if (s > m) { float f = expf(m - s); l *= f;
#pragma unroll
        for (int e = 0; e < 128; ++e) o[e] *= f;
        m = s; }
      float p = expf(s - m); l += p;
#pragma unroll
      for (int e = 0; e < 128; ++e) o[e] += p * vp[e];
    }
  }
  float il = 1.f / l;
  float* op = OC + ((long)cm * T + (long)b * SEQ + q) * C + h * 128;
#pragma unroll
  for (int e = 0; e < 128; ++e) op[e] = o[e] * il;
}
__global__ __launch_bounds__(256) void diff_combine(const float* OC, const float* lq1, const float* lk1, const float* lq2, const float* lk2, const float* subln_g, float* Y) {
  const int idx = blockIdx.x * 4 + (threadIdx.x >> 6), lane = threadIdx.x & 63; const int t = idx >> 2, h = idx & 3;
  float s1 = lq1[lane] * lk1[lane], s2 = lq2[lane] * lk2[lane];
  for (int q = 1; q < 64; q <<= 1) { s1 += __shfl_xor(s1, q); s2 += __shfl_xor(s2, q); }
  const float lam = expf(s1) - expf(s2) + 0.2f;
  const float* o0 = OC + (long)t * C + h * 128; const float* o1 = OC + ((long)T + t) * C + h * 128;
  float a = o0[lane] - lam * o1[lane], bb = o0[lane + 64] - lam * o1[lane + 64];
  float ss = a * a + bb * bb; for (int q = 1; q < 64; q <<= 1) ss += __shfl_xor(ss, q);
  float rs = 1.0f / sqrtf(ss * (1.f / 128.f) + NORM_EPS);
  Y[(long)t * D + C + h * 128 + lane] = a * rs * subln_g[lane] * 0.8f;
  Y[(long)t * D + C + h * 128 + lane + 64] = bb * rs * subln_g[lane + 64] * 0.8f;
}

__global__ __launch_bounds__(256) void softmax256(float* S, long nseg) {
  long seg = (long)blockIdx.x * 4 + (threadIdx.x >> 6); int lane = threadIdx.x & 63; if (seg >= nseg) return;
  float* p = S + seg * 256; float v[4]; float m = -INFINITY;
  for (int i = 0; i < 4; ++i) { v[i] = p[lane + 64 * i]; m = fmaxf(m, v[i]); }
  for (int q = 1; q < 64; q <<= 1) m = fmaxf(m, __shfl_xor(m, q));
  float l = 0.f; for (int i = 0; i < 4; ++i) { v[i] = expf(v[i] - m); l += v[i]; }
  for (int q = 1; q < 64; q <<= 1) l += __shfl_xor(l, q);
  float il = 1.f / l; for (int i = 0; i < 4; ++i) p[lane + 64 * i] = v[i] * il;
}

__global__ __launch_bounds__(64) void router_naive(const float* h3, const float* wr, const float* br, int* cnt, int* list, float* gate) {
  const int t = blockIdx.x * 64 + threadIdx.x;
  float lg[NE];
#pragma unroll
  for (int e = 0; e < NE; ++e) lg[e] = br[e];
  const float* hr = h3 + (long)t * D;
  for (int k = 0; k < D; ++k) { float hv = hr[k];
#pragma unroll
    for (int e = 0; e < NE; ++e) lg[e] += hv * wr[k * NE + e]; }
  int sel[4]; float val[4];
#pragma unroll
  for (int s = 0; s < 4; ++s) { float best = -INFINITY; int bi = 0;
#pragma unroll
    for (int e = 0; e < NE; ++e) { bool ok = lg[e] > best; best = ok ? lg[e] : best; bi = ok ? e : bi; }
    sel[s] = bi; val[s] = best;
#pragma unroll
    for (int e = 0; e < NE; ++e) if (e == bi) lg[e] = -INFINITY; }
  float mx = val[0], sum = 0.f, pe[4];
  for (int s = 0; s < 4; ++s) { pe[s] = expf(val[s] - mx); sum += pe[s]; }
  for (int s = 0; s < 4; ++s) { int slot = t * 4 + s; gate[slot] = pe[s] / sum; int pos = atomicAdd(&cnt[sel[s]], 1); list[(long)sel[s] * T + pos] = slot; }
}

__global__ __launch_bounds__(256) void final_naive(const float* x2, const float* ye, const float* g, float* out) {
  int row = blockIdx.x * 4 + (threadIdx.x >> 6), lane = threadIdx.x & 63;
  float v[16]; float ss = 0.f;
  for (int i = 0; i < 16; ++i) { int cidx = lane + 64 * i; float a = x2[(long)row * D + cidx];
    for (int k = 0; k < 4; ++k) a += ye[((long)row * 4 + k) * D + cidx];
    v[i] = a; ss += a * a; }
  for (int o = 1; o < 64; o <<= 1) ss += __shfl_xor(ss, o);
  float rs = 1.0f / sqrtf(ss * (1.f / D) + NORM_EPS);
  for (int i = 0; i < 16; ++i) out[(long)row * D + lane + 64 * i] = v[i] * rs * g[lane + 64 * i];
}

extern "C" void kernel_launch(void* const* d_in, const int* in_sizes, int n_in, void* d_out, int out_size, void* d_ws, size_t ws_size, hipStream_t stream) {
  const float* x = (const float*)d_in[0]; const float* mem = (const float*)d_in[1]; const float* norm_mix_g = (const float*)d_in[2]; const float* w_in = (const float*)d_in[3];
  const float* shift_mu = (const float*)d_in[4]; const float* w0 = (const float*)d_in[5]; const float* w_decay_up = (const float*)d_in[6]; const float* a0 = (const float*)d_in[7];
  const float* w_iclr_up = (const float*)d_in[8]; const float* w_gate_up = (const float*)d_in[9]; const float* k_k = (const float*)d_in[10]; const float* k_a = (const float*)d_in[11];
  const float* r_k = (const float*)d_in[12]; const float* lnx_g = (const float*)d_in[13]; const float* lnx_b = (const float*)d_in[14];
  const float* lq1 = (const float*)d_in[15]; const float* lk1 = (const float*)d_in[16]; const float* lq2 = (const float*)d_in[17]; const float* lk2 = (const float*)d_in[18];
  const float* subln_g = (const float*)d_in[19]; const float* w_out = (const float*)d_in[20]; const float* norm_cross_g = (const float*)d_in[21]; const float* norm_mem_g = (const float*)d_in[22];
  const float* w_cq = (const float*)d_in[23]; const float* w_ckv = (const float*)d_in[24]; const float* w_co = (const float*)d_in[25]; const float* norm_ffn_g = (const float*)d_in[26];
  const float* w_router = (const float*)d_in[27]; const float* b_router = (const float*)d_in[28]; const float* w1 = (const float*)d_in[29]; const float* b1 = (const float*)d_in[30];
  const float* w2 = (const float*)d_in[31]; const float* b2 = (const float*)d_in[32]; const float* norm_final_g = (const float*)d_in[33];
  float* out = (float*)d_out;
  char* ws = (char*)d_ws; const size_t MiB = 1u << 20;
  float* H0 = (float*)(ws + 0 * MiB);
  float* X2 = (float*)(ws + 64 * MiB);
  int* CNT = (int*)(ws + 128 * MiB);
  int* LIST = (int*)(ws + 129 * MiB);
  float* GATEV = (float*)(ws + 132 * MiB);
  float* MN = (float*)(ws + 136 * MiB);
  float* MKV = (float*)(ws + 140 * MiB);
  float* PROJ = (float*)(ws + 160 * MiB);
  float* RS = (float*)(ws + 370 * MiB);
  float* GG = (float*)(ws + 562 * MiB);
  float* Y = (float*)(ws + 594 * MiB);
  float* X1 = (float*)(ws + 658 * MiB);
  float* Q = (float*)(ws + 722 * MiB);
  float* S = (float*)(ws + 786 * MiB);
  float* O = (float*)(ws + 850 * MiB);
  float* OC = (float*)(ws + 722 * MiB);
  float* ACT = (float*)(ws + 160 * MiB);
  float* YE = (float*)(ws + 416 * MiB);
  const long TC = (long)T * C;
  float *R = RS, *W = RS + TC, *K = RS + 2 * TC, *V = RS + 3 * TC, *KK = RS + 4 * TC, *KKA = RS + 5 * TC;

  (void)hipMemsetAsync(CNT, 0, 128, stream);
  rmsnorm_rows<<<T / 4, 256, 0, stream>>>(x, norm_mix_g, H0, T);
  gemm_naive<<<dim3((MIX_IN + 63) / 64, T / 64, 1), 256, 0, stream>>>(ARows{H0, D, 0, 0, 1, T}, BMat<false>{w_in, MIX_IN, 0, 0, 1}, EpiStore{PROJ, MIX_IN, 0, 0, 1, nullptr, 1.f, 0}, MIX_IN, D);
  rwkv_prep<<<T, 512, 0, stream>>>(PROJ, shift_mu, w0, w_decay_up, a0, w_iclr_up, w_gate_up, k_k, k_a, R, W, K, V, KK, KKA, GG);
  rwkv_scan<<<BATCH * NH, 64, 0, stream>>>(R, W, K, V, KK, KKA, GG, r_k, lnx_g, lnx_b, Y);
  diff_attn_naive<<<dim3(SEQ / 256, 8, BATCH), 256, 0, stream>>>(PROJ, OC);
  diff_combine<<<T * 4 / 4, 256, 0, stream>>>(OC, lq1, lk1, lq2, lk2, subln_g, Y);
  gemm_naive<<<dim3(D / 64, T / 64, 1), 256, 0, stream>>>(ARows{Y, D, 0, 0, 1, T}, BMat<false>{w_out, D, 0, 0, 1}, EpiStore{X1, D, 0, 0, 1, x, 1.f, 0}, D, D);
  rmsnorm_rows<<<T / 4, 256, 0, stream>>>(X1, norm_cross_g, H0, T);
  rmsnorm_rows<<<BATCH * MEM / 4, 256, 0, stream>>>(mem, norm_mem_g, MN, BATCH * MEM);
  gemm_naive<<<dim3(D / 64, T / 64, 1), 256, 0, stream>>>(ARows{H0, D, 0, 0, 1, T}, BMat<false>{w_cq, D, 0, 0, 1}, EpiStore{Q, D, 0, 0, 1, nullptr, 1.f, 0}, D, D);
  gemm_naive<<<dim3(2 * D / 64, BATCH * MEM / 64, 1), 256, 0, stream>>>(ARows{MN, D, 0, 0, 1, BATCH * MEM}, BMat<false>{w_ckv, 2 * D, 0, 0, 1}, EpiStore{MKV, 2 * D, 0, 0, 1, nullptr, 1.f, 0}, 2 * D, D);
  gemm_naive<<<dim3(MEM / 64, SEQ / 64, BATCH * 4), 256, 0, stream>>>(ARows{Q, D, (long)SEQ * D, 256, 4, SEQ}, BMat<true>{MKV, 2 * D, (long)MEM * 2 * D, 256, 4}, EpiStore{S, D, (long)SEQ * D, 256, 4, nullptr, 0.0625f, 0}, MEM, 256);
  softmax256<<<(T * 4) / 4, 256, 0, stream>>>(S, (long)T * 4);
  gemm_naive<<<dim3(256 / 64, SEQ / 64, BATCH * 4), 256, 0, stream>>>(ARows{S, D, (long)SEQ * D, 256, 4, SEQ}, BMat<false>{MKV + D, 2 * D, (long)MEM * 2 * D, 256, 4}, EpiStore{O, D, (long)SEQ * D, 256, 4, nullptr, 1.f, 0}, 256, MEM);
  gemm_naive<<<dim3(D / 64, T / 64, 1), 256, 0, stream>>>(ARows{O, D, 0, 0, 1, T}, BMat<false>{w_co, D, 0, 0, 1}, EpiStore{X2, D, 0, 0, 1, X1, 1.f, 0}, D, D);
  rmsnorm_rows<<<T / 4, 256, 0, stream>>>(X2, norm_ffn_g, H0, T);
  router_naive<<<T / 64, 64, 0, stream>>>(H0, w_router, b_router, CNT, LIST, GATEV);
  gemm_naive<<<dim3(2 * FF / 64, T / 64, NE), 256, 0, stream>>>(AGather{H0, D, LIST, CNT, T, 4}, BMat<false>{w1, 2 * FF, (long)D * 2 * FF, 0, 1}, EpiSwiglu{ACT, LIST, T, b1}, 2 * FF, D);
  gemm_naive<<<dim3(D / 64, T / 64, NE), 256, 0, stream>>>(AGather{ACT, FF, LIST, CNT, T, 1}, BMat<false>{w2, D, (long)FF * D, 0, 1}, EpiMoeOut{YE, LIST, T, b2, GATEV}, D, FF);
  final_naive<<<T / 4, 256, 0, stream>>>(X2, YE, norm_final_g, out);
}
```

```cpp
#include <hip/hip_runtime.h>
#include <math.h>
#include <stdint.h>
#include <cstdio>

constexpr int D = 1024, BATCH = 4, SEQ = 4096, T = BATCH * SEQ, MEM = 256;
constexpr int C = 512, NH = 8, HN = 64, RWKV_IN = 1824, MIX_IN = 3360, PROJ_LD = 3584;
constexpr int NE = 32, FF = 1024;
constexpr float NORM_EPS = 1e-5f, GN_EPS = 64e-5f;
constexpr int NWAVES = 8, NTHR = 512;
constexpr int XROWS = T * 4 + NE * 256;

#ifndef REFRESH_OPAQUE
#define REFRESH_OPAQUE 1
#endif
#define GAS __attribute__((address_space(1)))
#define LAS __attribute__((address_space(3)))
typedef unsigned short bf16;
typedef unsigned v4u __attribute__((ext_vector_type(4)));
typedef unsigned v2u __attribute__((ext_vector_type(2)));
typedef float f32x4 __attribute__((ext_vector_type(4)));
typedef short bf16x8 __attribute__((ext_vector_type(8)));
typedef GAS unsigned gu32;
#define RLX_AGENT __ATOMIC_RELAXED, __HIP_MEMORY_SCOPE_AGENT
#define LDS_WAIT() asm volatile("s_waitcnt lgkmcnt(0)" ::: "memory")
#define VM_WAIT() asm volatile("s_waitcnt vmcnt(0)" ::: "memory")
__device__ __forceinline__ unsigned f2bf(float f) { unsigned u = __builtin_bit_cast(unsigned, f); return (u + 0x7fffu + ((u >> 16) & 1u)) >> 16; }
__device__ __forceinline__ unsigned pk2(float lo, float hi) { return f2bf(lo) | (f2bf(hi) << 16); }
typedef float f32x2_t __attribute__((ext_vector_type(2))); typedef __bf16 bf16x2_t __attribute__((ext_vector_type(2)));
__device__ __forceinline__ unsigned cvtpk(float lo, float hi) { f32x2_t v = {lo, hi}; bf16x2_t b = __builtin_convertvector(v, bf16x2_t); return __builtin_bit_cast(unsigned, b); }
__device__ __forceinline__ float bf2f(bf16 v) { return __uint_as_float((unsigned)v << 16); }
__device__ __forceinline__ int lane_id() { int l; asm volatile("v_mbcnt_lo_u32_b32 %0, -1, 0\n\tv_mbcnt_hi_u32_b32 %0, -1, %0" : "=v"(l)); return l; }
__device__ __forceinline__ float wave_sum(float v) {
#pragma unroll
    for (int o = 1; o < 64; o <<= 1) v += __shfl_xor(v, o);
    return v;
}
__device__ __forceinline__ float swiglu_f(float g, float l) { g = fminf(g, 7.f); l = fminf(fmaxf(l, -7.f), 7.f); return g * __builtin_amdgcn_rcpf(1.f + __expf(-1.702f * g)) * (l + 1.f); }

constexpr size_t MiB = 1u << 20;
constexpr size_t WS_CTL = 0, CTL_ZERO_BYTES = 1 * MiB;
constexpr int CW_BAR = 4096;
constexpr size_t CTL_SS1 = 256 * 1024, CTL_SS2 = 320 * 1024, CTL_CNT = 384 * 1024, CTL_Q = 448 * 1024, CTL_NRM = 480 * 1024, CTL_RDY = 512 * 1024;
constexpr size_t WS_RSTD0 = 1 * MiB;
constexpr size_t WS_GATE = 2 * MiB;
constexpr size_t WS_ROWOF = 3 * MiB;
constexpr size_t WS_TOKOF = 5 * MiB + 512 * 1024;
constexpr size_t WS_LIST = 4 * MiB;
constexpr size_t WS_RS2 = 6 * MiB;
constexpr size_t WS_RG = 7 * MiB;
constexpr size_t WS_WIN_T = 8 * MiB;
constexpr size_t WS_WOUT_T = 15 * MiB;
constexpr size_t WS_WCQ_N = 17 * MiB;
constexpr size_t WS_WCKV_T = 19 * MiB;
constexpr size_t WS_WCO_T = 23 * MiB;
constexpr size_t WS_MN = 25 * MiB;
constexpr size_t WS_MKV = 27 * MiB;
constexpr size_t WS_WQK_T = 31 * MiB;
constexpr size_t WS_WVO_T = 39 * MiB;
constexpr size_t WS_WL = 47 * MiB;
constexpr size_t WS_W1_T = 48 * MiB;
constexpr size_t WS_W2_T = 176 * MiB;
constexpr size_t WS_XB = 240 * MiB;
constexpr size_t WS_PROJ = 272 * MiB;
constexpr size_t WS_Y = 384 * MiB;
constexpr size_t WS_X1 = 416 * MiB;
constexpr size_t WS_X1B = 480 * MiB;
constexpr size_t WS_P = 512 * MiB;
constexpr size_t WS_X2 = 544 * MiB;
constexpr size_t WS_X2B = 608 * MiB;
constexpr size_t WS_XG = 640 * MiB;
constexpr size_t WS_ACT = 784 * MiB;
constexpr size_t WS_END = 928 * MiB;
constexpr size_t WS_RS = 640 * MiB;
constexpr size_t WS_LW = 720 * MiB;
constexpr size_t WS_GG = 832 * MiB;
constexpr size_t WS_OC = 864 * MiB;
constexpr size_t WS_GF = 416 * MiB, WS_HT = 448 * MiB, WS_RF = 512 * MiB, WS_Y0 = 528 * MiB, WS_YRAW = 560 * MiB;
constexpr size_t WS_TMP = 640 * MiB;
namespace pg8 {
#define PG8_LAS __attribute__((address_space(3)))
constexpr int BM = 256, BK = 64, HALF = 128, HTB = HALF * BK * 2  , STAGE_BYTES = 8 * HTB, NXCD = 8, WGM = 8;
__host__ __device__ __forceinline__ int lds_byte(int r, int c) { const int st = (r >> 4) * 2 + (c >> 5), rr = r & 15, cc = c & 31, ob = rr * 64 + cc * 2; return st * 1024 + (ob ^ (((ob >> 9) & 1) << 5)); }
__host__ __device__ __forceinline__ void stage_rc(int b, int& R, int& C) { const int st = b / 1024, sb = b % 1024, swz = sb ^ (((sb >> 9) & 1) << 5); R = (st >> 1) * 16 + swz / 64; C = (st & 1) * 32 + (swz % 64) / 2; }
__host__ __device__ __forceinline__ int perm32(int rho) { const int n = rho >> 4, i = rho & 15; return 8 * (i >> 2) + 4 * n + (i & 3); }

struct Unit { const char* A; const char* B; const int* rows; int row0, col0, z, pad; };

__device__ __forceinline__ void tile_of(int L, int nM, int nN, int& pm, int& pn) {
    const int nwg = nM * nN; int wgid = L; { const int q = nwg / NXCD, r = nwg % NXCD, xcd = wgid % NXCD, off = wgid / NXCD; wgid = (xcd < r ? xcd * (q + 1) : r * (q + 1) + (xcd - r) * q) + off; }
    const int nig = WGM * nN, gid = wgid / nig, fm = gid * WGM, gsz = (nM - fm) < WGM ? (nM - fm) : WGM;
    pm = fm + ((wgid % nig) % gsz); pn = (wgid % nig) / gsz;
}
struct GridSched {
    const char* A; const char* B; int lda, ldb, nM, nN, G, c, first, rows_per_z; size_t zstrideB;
    __device__ __forceinline__ bool next(int i, Unit& u) const {
        const long L = (long)i * G + c - first; if (L < 0 || L >= (long)nM * nN) return false;
        int pm, pn; tile_of((int)L, nM, nN, pm, pn);
        u.row0 = pm * BM; u.col0 = pn * BM; u.z = u.row0 / rows_per_z; u.pad = 0; u.rows = nullptr;
        u.A = A + (size_t)u.row0 * lda * 2; u.B = B + (size_t)u.z * zstrideB + (size_t)u.col0 * ldb * 2; return true; }
    __device__ __forceinline__ void a_ready(const Unit&) const {}
    __device__ __forceinline__ void done(const Unit&) const {}
};
__device__ __forceinline__ unsigned cvt_pk_bf16(float lo, float hi) { unsigned r; asm volatile("v_cvt_pk_bf16_f32 %0, %1, %2" : "=v"(r) : "v"(lo), "v"(hi)); return r; }

#define EPI_ROWS(...) _Pragma("unroll") for (int ai = 0; ai < 2; ++ai) _Pragma("unroll") for (int m = 0; m < 4; ++m) { const int row = u.row0 + ai * HALF + wr * 64 + m * 16 + fr; __VA_ARGS__ }
#define EPI_COLS(...) _Pragma("unroll") for (int bj = 0; bj < 2; ++bj) { const int col = u.col0 + bj * HALF + wc * 32 + 8 * fq; const f32x4 a0 = acc[ai][bj][m][0], a1 = acc[ai][bj][m][1]; __VA_ARGS__ }

struct EpiBf16 {
    static constexpr bool PERM = true, AFTER_DRAIN = false;
    bf16* O; int ldc; const float* rs;
    __device__ __forceinline__ void operator()(const f32x4 (&acc)[2][2][4][2], const Unit& u, int wr, int wc, int fr, int fq) const {
        EPI_ROWS( const float s = rs ? rs[row] : 1.f; bf16* rowp = O + (size_t)row * ldc;
            EPI_COLS( v4u w; w.x = cvt_pk_bf16(a0[0] * s, a0[1] * s); w.y = cvt_pk_bf16(a0[2] * s, a0[3] * s); w.z = cvt_pk_bf16(a1[0] * s, a1[1] * s); w.w = cvt_pk_bf16(a1[2] * s, a1[3] * s);
                      *(v4u*)(rowp + col) = w; ) )
    }
};
struct EpiResid {
    static constexpr bool PERM = true, AFTER_DRAIN = false;
    const float* R; const bf16* Rb; float* Xn; bf16* XnB; float* SS;
    __device__ __forceinline__ void operator()(const f32x4 (&acc)[2][2][4][2], const Unit& u, int wr, int wc, int fr, int fq) const {
        EPI_ROWS( float q = 0.f; const size_t ro = (size_t)row * D;
            EPI_COLS( f32x4 r0, r1;
                      if (R) { r0 = *(const GAS f32x4*)(R + ro + col); r1 = *(const GAS f32x4*)(R + ro + col + 4); }
                      else { const v4u rb = *(const GAS v4u*)(Rb + ro + col); r0 = (f32x4){__uint_as_float(rb.x << 16), __uint_as_float(rb.x & 0xffff0000u), __uint_as_float(rb.y << 16), __uint_as_float(rb.y & 0xffff0000u)};
                             r1 = (f32x4){__uint_as_float(rb.z << 16), __uint_as_float(rb.z & 0xffff0000u), __uint_as_float(rb.w << 16), __uint_as_float(rb.w & 0xffff0000u)}; }
                      const f32x4 x0 = r0 + a0, x1 = r1 + a1;
                      if (Xn) { *(f32x4*)(Xn + ro + col) = x0; *(f32x4*)(Xn + ro + col + 4) = x1; }
                      v4u w; w.x = cvt_pk_bf16(x0[0], x0[1]); w.y = cvt_pk_bf16(x0[2], x0[3]); w.z = cvt_pk_bf16(x1[0], x1[1]); w.w = cvt_pk_bf16(x1[2], x1[3]); *(v4u*)(XnB + ro + col) = w;
                      q += (x0[0] * x0[0] + x0[1] * x0[1]) + (x0[2] * x0[2] + x0[3] * x0[3]) + (x1[0] * x1[0] + x1[1] * x1[1]) + (x1[2] * x1[2] + x1[3] * x1[3]); )
            q += __shfl_xor(q, 16); q += __shfl_xor(q, 32);
            if (fq == 0) atomicAdd(SS + row, q); )
    }
};
struct EpiMoe1 {
    static constexpr bool PERM = true, AFTER_DRAIN = false;
    bf16* ACT; const float* rs; const float* b1;
    __device__ __forceinline__ void operator()(const f32x4 (&acc)[2][2][4][2], const Unit& u, int wr, int wc, int fr, int fq) const {
        EPI_ROWS( const float s = rs[row];
            EPI_COLS( const f32x4 c0 = *(const f32x4*)(b1 + (size_t)u.z * 2 * FF + col), c1 = *(const f32x4*)(b1 + (size_t)u.z * 2 * FF + col + 4);
                      const f32x4 h0 = a0 * s + c0, h1 = a1 * s + c1;
                      v2u w; w.x = cvt_pk_bf16(swiglu_f(h0[0], h0[1]), swiglu_f(h0[2], h0[3])); w.y = cvt_pk_bf16(swiglu_f(h1[0], h1[1]), swiglu_f(h1[2], h1[3]));
                      *(v2u*)(ACT + (size_t)row * FF + (col >> 1)) = w; ) )
    }
};
struct EpiMoe2 {
    static constexpr bool PERM = true, AFTER_DRAIN = false;
    bf16* YE; const float* rg; const float* b2;
    __device__ __forceinline__ void operator()(const f32x4 (&acc)[2][2][4][2], const Unit& u, int wr, int wc, int fr, int fq) const {
        EPI_ROWS( const float s = rg[row];
            EPI_COLS( const f32x4 c0 = *(const f32x4*)(b2 + (size_t)u.z * D + col), c1 = *(const f32x4*)(b2 + (size_t)u.z * D + col + 4);
                      const f32x4 h0 = (a0 + c0) * s, h1 = (a1 + c1) * s;
                      v4u w; w.x = cvt_pk_bf16(h0[0], h0[1]); w.y = cvt_pk_bf16(h0[2], h0[3]); w.z = cvt_pk_bf16(h1[0], h1[1]); w.w = cvt_pk_bf16(h1[2], h1[3]);
                      *(v4u*)(YE + (size_t)row * D + col) = w; ) )
    }
};

struct EpiSoftmax {
    static constexpr bool PERM = true, AFTER_DRAIN = false;
    bf16* O; const float* ss; float c2; PG8_LAS float* x;
    __device__ __forceinline__ void operator()(f32x4 (&acc)[2][2][4][2], const Unit& u, int wr, int wc, int fr, int fq) const {
        PG8_LAS float* MX = x; PG8_LAS float* SX = x + 1024;
        EPI_ROWS( const float s = (1.0f / sqrtf(ss[row] * (1.f / D) + NORM_EPS)) * c2; float mx = -INFINITY;
            _Pragma("unroll") for (int bj = 0; bj < 2; ++bj) _Pragma("unroll") for (int n = 0; n < 2; ++n) { acc[ai][bj][m][n] = acc[ai][bj][m][n] * s; const f32x4 v = acc[ai][bj][m][n]; mx = fmaxf(fmaxf(mx, fmaxf(v[0], v[1])), fmaxf(v[2], v[3])); }
            mx = fmaxf(mx, __shfl_xor(mx, 16)); mx = fmaxf(mx, __shfl_xor(mx, 32));
            if (fq == 0) MX[(ai * HALF + wr * 64 + m * 16 + fr) * 4 + wc] = mx; )
        asm volatile("s_waitcnt lgkmcnt(0)" ::: "memory"); __builtin_amdgcn_s_barrier(); asm volatile("" ::: "memory");
        EPI_ROWS( const f32x4 mm = *(const PG8_LAS f32x4*)(MX + (ai * HALF + wr * 64 + m * 16 + fr) * 4); const float mx = fmaxf(fmaxf(mm[0], mm[1]), fmaxf(mm[2], mm[3])); float l = 0.f;
            _Pragma("unroll") for (int bj = 0; bj < 2; ++bj) _Pragma("unroll") for (int n = 0; n < 2; ++n) { f32x4 v = acc[ai][bj][m][n];
                v[0] = __builtin_amdgcn_exp2f(v[0] - mx); v[1] = __builtin_amdgcn_exp2f(v[1] - mx); v[2] = __builtin_amdgcn_exp2f(v[2] - mx); v[3] = __builtin_amdgcn_exp2f(v[3] - mx); acc[ai][bj][m][n] = v; l += (v[0] + v[1]) + (v[2] + v[3]); }
            l += __shfl_xor(l, 16); l += __shfl_xor(l, 32);
            if (fq == 0) SX[(ai * HALF + wr * 64 + m * 16 + fr) * 4 + wc] = l; (void)row; )
        asm volatile("s_waitcnt lgkmcnt(0)" ::: "memory"); __builtin_amdgcn_s_barrier(); asm volatile("" ::: "memory");
        EPI_ROWS( const f32x4 ll = *(const PG8_LAS f32x4*)(SX + (ai * HALF + wr * 64 + m * 16 + fr) * 4); const float il = 1.0f / ((ll[0] + ll[1]) + (ll[2] + ll[3])); bf16* rowp = O + (size_t)row * D;
            EPI_COLS( v4u w; w.x = cvt_pk_bf16(a0[0] * il, a0[1] * il); w.y = cvt_pk_bf16(a0[2] * il, a0[3] * il); w.z = cvt_pk_bf16(a1[0] * il, a1[1] * il); w.w = cvt_pk_bf16(a1[2] * il, a1[3] * il);
                      *(v4u*)(rowp + col) = w; ) )
    }
};
struct MoeSched {
    const char* A; const char* B; const int* tokof; int lda, ldb, nN, G, c; volatile PG8_LAS unsigned* tab; size_t estrideB;
    __device__ __forceinline__ bool next(int i, Unit& u) const {
        const int total_tiles = (int)tab[64]; const int U = total_tiles * nN; const long L = (long)i * G + c; if (L >= U) return false;
        int wgid = (int)L; { const int q = U / NXCD, r = U % NXCD, xcd = wgid % NXCD, off = wgid / NXCD; wgid = (xcd < r ? xcd * (q + 1) : r * (q + 1) + (xcd - r) * q) + off; }
        const int lane = lane_id(); const int ebase_l = (int)tab[lane & 31];
        const unsigned long long mk = __ballot(lane < 32 && (ebase_l / BM) * nN <= wgid);
        const int e = __builtin_amdgcn_readfirstlane(__popcll(mk & 0xffffffffull) - 1);
        const int base = (int)tab[e], cnt = (int)tab[32 + e];
        const int te = (cnt + BM - 1) / BM, idx = wgid - (base / BM) * nN, mt = idx % te, pn = idx / te;
        u.row0 = base + mt * BM; u.col0 = pn * BM; u.z = e; u.pad = 0; u.rows = tokof ? tokof + u.row0 : nullptr;
        u.A = tokof ? A : A + (size_t)u.row0 * lda * 2; u.B = B + (size_t)e * estrideB + (size_t)u.col0 * ldb * 2; return true; }
    __device__ __forceinline__ void a_ready(const Unit&) const {}
    __device__ __forceinline__ void done(const Unit&) const {}
};
struct FoldSched {
    const char* MKV; const char* W; int mode, G, c, first;
    __device__ __forceinline__ bool next(int i, Unit& u) const {
        const long L = (long)i * G + c - first; if (L < 0 || L >= 64) return false;
        const int z = (int)L >> 2, q = (int)L & 3, b = z >> 2, h = z & 3; u.z = z; u.pad = 0; u.rows = nullptr;
        if (mode == 0) { u.A = MKV + ((size_t)b * MEM * 2 * D + h * 256) * 2; u.B = W + ((size_t)q * 256 * D + h * 256) * 2; u.row0 = b * D + h * 256; u.col0 = q * 256; }
        else { u.A = W + ((size_t)q * 256 * D + h * 256) * 2; u.B = MKV + ((size_t)b * MEM * 2 * D + D + h * 256) * 2; u.row0 = b * D + q * 256; u.col0 = h * 256; }
        return true; }
    __device__ __forceinline__ void a_ready(const Unit&) const {}
    __device__ __forceinline__ void done(const Unit&) const {}
};

template <class Epi, class Sched, bool ALIGN_EPI = false, bool GATHER = false>
__device__ __forceinline__ void gemm_phase(PG8_LAS unsigned char* lds, const int wave_, const int K, const int lda, const int ldb, const Sched& S, const Epi& E) {
    constexpr bool SP2 = true;
    const int lane = lane_id(), wid = wave_, tid = wid * 64 + lane, wr = wid >> 2, wc = wid & 3, fr = lane & 15, fq = lane >> 4;
    int nt = K / BK; asm volatile("" : "+s"(nt));
    unsigned voffA[2], voffB[2];
#pragma unroll
    for (int i = 0; i < 2; ++i) { int R, C; stage_rc(tid * 16 + i * 8192, R, C); const int Rb = Epi::PERM ? ((R & ~31) + perm32(R & 31)) : R;
        voffA[i] = (unsigned)(R * lda + C) * 2u; voffB[i] = (unsigned)(Rb * ldb + C) * 2u; }
    int gR[2], gC[2];
#pragma unroll
    for (int i = 0; i < 2; ++i) { int R, C; stage_rc(tid * 16 + i * 8192, R, C); gR[i] = R; gC[i] = C * 2; }
    PG8_LAS int* gtab = (PG8_LAS int*)(lds + STAGE_BYTES + 1024);
    const size_t kstep = (size_t)(BK * 2);
    const size_t hstepA = (size_t)HALF * lda * 2, hstepB = (size_t)HALF * ldb * 2;
    const unsigned ldsw = (unsigned)wid * 1024u;
    const int aoff = lds_byte(wr * 64 + fr, fq * 8), boff = lds_byte(wc * 32 + fr, fq * 8);
#define PG8_SA(b, h) (((b) * 2 + (h)) * HTB)
#define PG8_SB(b, h) ((4 + (b) * 2 + (h)) * HTB)
#define PG8_STAGE(bufoff, gbase, voff) do { _Pragma("unroll") for (int _i = 0; _i < 2; ++_i) \
        __builtin_amdgcn_global_load_lds((const unsigned*)((const char*)(gbase) + (voff)[_i]), (PG8_LAS unsigned*)(lds + (bufoff) + ldsw + _i * 8192), 16, 0, 0); } while (0)
#define PG8_STAGE_A(bufoff, gbase, h, tsel) do { if constexpr (GATHER) { _Pragma("unroll") for (int _i = 0; _i < 2; ++_i) { const unsigned _o = (unsigned)gtab[(tsel) * 256 + (h) * 128 + gR[_i]] * (unsigned)(lda * 2) + (unsigned)gC[_i]; \
        __builtin_amdgcn_global_load_lds((const unsigned*)((const char*)(gbase) + _o), (PG8_LAS unsigned*)(lds + (bufoff) + ldsw + _i * 8192), 16, 0, 0); } } \
    else { _Pragma("unroll") for (int _i = 0; _i < 2; ++_i) __builtin_amdgcn_global_load_lds((const unsigned*)((const char*)(gbase) + (h) * hstepA + voffA[_i]), (PG8_LAS unsigned*)(lds + (bufoff) + ldsw + _i * 8192), 16, 0, 0); } } while (0)
#define PG8_LDA(dst, b, h) do { _Pragma("unroll") for (int m = 0; m < 4; ++m) _Pragma("unroll") for (int k = 0; k < 2; ++k) dst[m][k] = *(const PG8_LAS bf16x8*)(lds + PG8_SA(b, h) + aoff + m * 2048 + k * 1024); } while (0)
#define PG8_LDB(dst, b, h) do { _Pragma("unroll") for (int n = 0; n < 2; ++n) _Pragma("unroll") for (int k = 0; k < 2; ++k) dst[n][k] = *(const PG8_LAS bf16x8*)(lds + PG8_SB(b, h) + boff + n * 2048 + k * 1024); } while (0)
#define PG8_MMA(ai, bj, At, Bt) do { __builtin_amdgcn_s_setprio(1); _Pragma("unroll") for (int m = 0; m < 4; ++m) _Pragma("unroll") for (int n = 0; n < 2; ++n) _Pragma("unroll") for (int k = 0; k < 2; ++k) \
        acc[ai][bj][m][n] = __builtin_amdgcn_mfma_f32_16x16x32_bf16(Bt[n][k], At[m][k], acc[ai][bj][m][n], 0, 0, 0); __builtin_amdgcn_s_setprio(0); } while (0)
#define PG8_WAIT_V(n) asm volatile("s_waitcnt vmcnt(" #n ")" ::: "memory")
#define PG8_WAIT_L(n) asm volatile("s_waitcnt lgkmcnt(" #n ")" ::: "memory")
#define PG8_BAR __builtin_amdgcn_s_barrier()
#define PG8_SCHED __builtin_amdgcn_sched_barrier(0)
    Unit cur, nxt; int ui = 0;
    if (!S.next(0, cur)) return;
    f32x4 acc[2][2][4][2];
#pragma unroll
    for (int a = 0; a < 2; ++a)
#pragma unroll
        for (int b = 0; b < 2; ++b)
#pragma unroll
            for (int m = 0; m < 4; ++m)
#pragma unroll
                for (int n = 0; n < 2; ++n) acc[a][b][m][n] = (f32x4){0.f, 0.f, 0.f, 0.f};
    bf16x8 At[4][2], B0[2][2], B1[2][2];
    const char* cA = cur.A; const char* cB = cur.B;
    int tc = 0;
    if constexpr (GATHER) { if (tid < 256) gtab[tid] = cur.rows[tid]; asm volatile("s_waitcnt lgkmcnt(0)" ::: "memory"); PG8_BAR; }
    S.a_ready(cur);
    if constexpr (SP2) {
        PG8_STAGE(PG8_SB(0, 0), cB, voffB); PG8_STAGE(PG8_SB(0, 1), cB + hstepB, voffB); PG8_STAGE_A(PG8_SA(0, 0), cA, 0, tc); PG8_STAGE_A(PG8_SA(0, 1), cA, 1, tc);
        if (wr == 1) PG8_BAR;
        PG8_WAIT_V(2); PG8_BAR;
        PG8_STAGE(PG8_SB(1, 0), cB + kstep, voffB); PG8_STAGE_A(PG8_SA(1, 0), cA + kstep, 0, tc); PG8_STAGE(PG8_SB(1, 1), cB + hstepB + kstep, voffB);
        PG8_WAIT_V(6); PG8_BAR;
    }
    for (;;) {
        const bool has_next = S.next(ui + 1, nxt);
        if constexpr (GATHER) { if (has_next && tid < 256) gtab[(tc ^ 1) * 256 + tid] = nxt.rows[tid]; }
        const char* nA = has_next ? nxt.A : cA; const char* nB = has_next ? nxt.B : cB;
        for (int t = 0; t < nt; t += 2) {
            const bool last = (t == nt - 2); const int tl = (last && has_next) ? (tc ^ 1) : tc;
            const char* a1 = cA + (size_t)(t + 1) * kstep;
            const char* a2 = last ? nA : cA + (size_t)(t + 2) * kstep; const char* b2 = last ? nB : cB + (size_t)(t + 2) * kstep;
            const char* a3 = a2 + kstep; const char* b3 = b2 + kstep;
            if (last && has_next) S.a_ready(nxt);
            if constexpr (SP2) {
            PG8_LDB(B0, 0, 0); PG8_LDB(B1, 0, 1); PG8_SCHED; PG8_LDA(At, 0, 0); PG8_STAGE_A(PG8_SA(1, 1), a1, 1, tc);
            PG8_WAIT_V(8); PG8_WAIT_L(0); PG8_BAR; PG8_MMA(0, 0, At, B0); PG8_MMA(0, 1, At, B1); PG8_BAR; PG8_SCHED;
            PG8_LDA(At, 0, 1); PG8_STAGE(PG8_SB(0, 0), b2, voffB); PG8_STAGE(PG8_SB(0, 1), b2 + hstepB, voffB); PG8_STAGE_A(PG8_SA(0, 0), a2, 0, tl);
            PG8_WAIT_V(8); PG8_WAIT_L(0); PG8_BAR; PG8_MMA(1, 0, At, B0); PG8_MMA(1, 1, At, B1); PG8_BAR; PG8_SCHED;
            PG8_LDB(B0, 1, 0); PG8_LDB(B1, 1, 1); PG8_SCHED; PG8_LDA(At, 1, 0); PG8_STAGE_A(PG8_SA(0, 1), a2, 1, tl);
            PG8_WAIT_V(8); PG8_WAIT_L(0); PG8_BAR; PG8_MMA(0, 0, At, B0); PG8_MMA(0, 1, At, B1); PG8_BAR; PG8_SCHED;
            PG8_LDA(At, 1, 1); PG8_STAGE(PG8_SB(1, 0), b3, voffB); PG8_STAGE(PG8_SB(1, 1), b3 + hstepB, voffB); PG8_STAGE_A(PG8_SA(1, 0), a3, 0, tl);
            PG8_WAIT_V(8); PG8_WAIT_L(0); PG8_BAR; PG8_MMA(1, 0, At, B0); PG8_MMA(1, 1, At, B1); PG8_BAR; PG8_SCHED;
            }
        }
        if constexpr (ALIGN_EPI) { if (wr == 0) PG8_BAR; }
        if constexpr (!Epi::AFTER_DRAIN) { E(acc, cur, wr, wc, fr, fq); S.done(cur); }
        if (!has_next) break;
#pragma unroll
        for (int a = 0; a < 2; ++a)
#pragma unroll
            for (int b = 0; b < 2; ++b)
#pragma unroll
                for (int m = 0; m < 4; ++m)
#pragma unroll
                    for (int n = 0; n < 2; ++n) acc[a][b][m][n] = (f32x4){0.f, 0.f, 0.f, 0.f};
        cur = nxt; cA = nA; cB = nB; ++ui; tc ^= 1;
        if constexpr (ALIGN_EPI) { if (wr == 1) PG8_BAR; }
    }
    PG8_WAIT_V(0);
    if constexpr (!ALIGN_EPI) { if (wr == 0) PG8_BAR; }
    PG8_BAR;
    if constexpr (Epi::AFTER_DRAIN) { E.fused(acc, cur, wr, wc, fr, fq, lds, wid, lane); S.done(cur); }
#undef PG8_SA
#undef PG8_SB
#undef PG8_STAGE
#undef PG8_STAGE_A
#undef PG8_LDA
#undef PG8_LDB
#undef PG8_MMA
#undef PG8_WAIT_V
#undef PG8_WAIT_L
#undef PG8_BAR
#undef PG8_SCHED
}
}
#define XB_TMO      128
#define XB_XCNT(j)  (256  + 64 * (j))
#define XB_XSUB(j)  (1280 + 64 * (j))
#define XB_XGEN(j)  (2304 + 64 * (j))
#define XB_TOP      3328
#define XB_TOPGEN   3392
#define XCD_BAR_WORDS 3456
#define XB_SPIN_CAP (1u << 24)

__device__ __forceinline__ unsigned xb_ld(unsigned* p)              { return __hip_atomic_load(p, __ATOMIC_RELAXED, __HIP_MEMORY_SCOPE_AGENT); }
__device__ __forceinline__ unsigned xb_add(unsigned* p, unsigned v) { return __hip_atomic_fetch_add(p, v, __ATOMIC_RELAXED, __HIP_MEMORY_SCOPE_AGENT); }
__device__ __forceinline__ unsigned xb_xcc_id() { return (unsigned)__builtin_amdgcn_s_getreg((3 << 11) | 20) & 0xFu; }
#define XB_SPIN(cond, bar) do { unsigned _sp = 0; while (cond) { __builtin_amdgcn_s_sleep(1); \
    if ((++_sp & 255u) == 0u) { if (xb_ld(&(bar)[XB_TMO])) break; if (_sp > XB_SPIN_CAP) { atomicAdd(&(bar)[XB_TMO], 1u); break; } } } } while (0)

struct XcdBarrier {
    unsigned* bar; unsigned x;
    volatile LAS unsigned* st;
};

__device__ __forceinline__ XcdBarrier xcd_barrier_post(unsigned* bar, volatile LAS unsigned* st, int wave_) {
    XcdBarrier b; b.bar = bar; b.x = xb_xcc_id(); b.st = st;
    if (wave_ == 0 && lane_id() == 0) (void)xb_add(&bar[XB_XCNT(b.x)], 1u);
    return b;
}
__device__ __forceinline__ void xcd_barrier_complete(unsigned* bar, unsigned x, unsigned& nloc, unsigned& nx) {
    const unsigned G = gridDim.x * gridDim.y * gridDim.z;
    unsigned sum, cnt, mine, sp = 0u;
    for (;;) {
        sum = 0u; cnt = 0u; mine = 0u;
#pragma unroll
        for (unsigned j = 0; j < 16; ++j) { const unsigned c = xb_ld(&bar[XB_XCNT(j)]); sum += c; cnt += (c > 0u) ? 1u : 0u; mine = (j == x) ? c : mine; }
        if (sum == G) break;
        __builtin_amdgcn_s_sleep(1);
        if ((++sp & 255u) == 0u) { if (xb_ld(&bar[XB_TMO])) break; if (sp > XB_SPIN_CAP) { atomicAdd(&bar[XB_TMO], 1u); break; } }
    }
    nloc = mine > 0u ? mine : 1u; nx = cnt > 0u ? cnt : 1u;
}

__device__ __forceinline__ void xcd_barrier(const XcdBarrier& b, int wave_) {
    asm volatile("s_waitcnt vmcnt(0)" ::: "memory");
    __syncthreads();
    if (wave_ == 0 && lane_id() == 0) {
        unsigned* bar = b.bar;
        __builtin_amdgcn_s_waitcnt(0);
        unsigned nloc = b.st[0], nx = b.st[1];
        if (nloc == 0u) { xcd_barrier_complete(bar, b.x, nloc, nx); b.st[0] = nloc; b.st[1] = nx; }
        const unsigned old = xb_add(&bar[XB_XSUB(b.x)], 1u);
        const unsigned gen = old / nloc;
        if (old + 1u == (gen + 1u) * nloc) {
            __builtin_amdgcn_fence(__ATOMIC_RELEASE, "agent");
            asm volatile("s_waitcnt vmcnt(0)" ::: "memory");
            const unsigned og = xb_add(&bar[XB_TOP], 1u);
            const unsigned tg = og / nx;
            if (og + 1u == (tg + 1u) * nx) xb_add(&bar[XB_TOPGEN], 1u);
            else XB_SPIN(xb_ld(&bar[XB_TOPGEN]) == tg, bar);
            __builtin_amdgcn_fence(__ATOMIC_ACQUIRE, "agent");
            xb_add(&bar[XB_XGEN(b.x)], 1u);
            asm volatile("s_waitcnt vmcnt(0)" ::: "memory");
        } else {
            XB_SPIN(xb_ld(&bar[XB_XGEN(b.x)]) == gen, bar);
            __builtin_amdgcn_fence(__ATOMIC_ACQUIRE, "agent");
            asm volatile("s_waitcnt vmcnt(0)" ::: "memory");
        }
    }
    __syncthreads();
}
constexpr int RING_OFF = 0, RING_BYTES = 131072;
constexpr int LDS_BYTES = 163840;
constexpr int LDSCTL_OFF = LDS_BYTES - 2048, MISC_OFF = LDSCTL_OFF + 320;
constexpr int EPIX_OFF = RING_BYTES + 1024;

struct Frame {
    LAS unsigned char* lds;
    volatile LAS unsigned* MISC;
    gu32* ctl;
    int tid, lane, wave;
    int vcu, G;
    int gw, NGW, gt, NGT;
};
__device__ __forceinline__ void refresh(Frame& F) {
    int lane = lane_id();
#if REFRESH_OPAQUE
    asm volatile("" : "+v"(lane));
#endif
    const int tid = F.wave * 64 + lane; F.tid = tid; F.lane = lane;
    F.gw = F.vcu * NWAVES + F.wave; F.NGW = F.G * NWAVES; F.gt = F.vcu * NTHR + tid; F.NGT = F.G * NTHR;
}
struct Args { const float* in[34]; float* out; unsigned char* ws; int ph_lo, ph_hi, li, pad; };

__device__ __forceinline__ void p0_transpose_item(const float* W, int ldw, int K, int N, const float* rowg, bf16* WT, LAS float* scr, int item, int lane, int qlo = 0, int qhi = 0, float qs = 1.f) {
    const int nblk = N / 32, kb = item / nblk, nb = item % nblk, k0 = 64 * kb, n0 = 32 * nb;
    {
        const int kr = lane >> 3, nc = (lane & 7) * 4;
#pragma unroll
        for (int j = 0; j < 8; ++j) { const int kk = 8 * j + kr; f32x4 v = *(const f32x4*)(W + (size_t)(k0 + kk) * ldw + n0 + nc); const float g = (rowg ? rowg[k0 + kk] : 1.f) * ((n0 >= qlo && n0 < qhi) ? qs : 1.f);
            scr[kk * 33 + nc] = v[0] * g; scr[kk * 33 + nc + 1] = v[1] * g; scr[kk * 33 + nc + 2] = v[2] * g; scr[kk * 33 + nc + 3] = v[3] * g; }
    }
    LDS_WAIT(); asm volatile("" ::: "memory");
    const int c = lane & 7;
#pragma unroll
    for (int j = 0; j < 4; ++j) { const int n = (lane >> 3) + 8 * j; const LAS float* s = scr + (8 * c) * 33 + n;
        v4u o; o.x = pk2(s[0 * 33], s[1 * 33]); o.y = pk2(s[2 * 33], s[3 * 33]); o.z = pk2(s[4 * 33], s[5 * 33]); o.w = pk2(s[6 * 33], s[7 * 33]);
        *(GAS v4u*)(WT + (size_t)(n0 + n) * K + k0 + 8 * c) = o; }
    LDS_WAIT(); asm volatile("" ::: "memory");
}
struct TItem { const GAS float* W; GAS bf16* WT; const GAS float* rowg; int ldw, K, k0, n0; };
__device__ __forceinline__ void p0_t_load(const TItem& t, f32x4 (&v)[8], float (&g)[8], int lane) {
    const int kr = lane >> 3, nc = (lane & 7) * 4;
#pragma unroll
    for (int j = 0; j < 8; ++j) { const int kk = 8 * j + kr; v[j] = __builtin_nontemporal_load((const GAS f32x4*)(t.W + (size_t)(t.k0 + kk) * t.ldw + t.n0 + nc)); g[j] = t.rowg ? t.rowg[t.k0 + kk] : 1.f; }
}
__device__ __forceinline__ void p0_t_finish(const TItem& t, const f32x4 (&v)[8], const float (&g)[8], LAS float* scr, int lane) {
    const int kr = lane >> 3, nc = (lane & 7) * 4;
#pragma unroll
    for (int j = 0; j < 8; ++j) { const int kk = 8 * j + kr; scr[kk * 33 + nc] = v[j][0] * g[j]; scr[kk * 33 + nc + 1] = v[j][1] * g[j]; scr[kk * 33 + nc + 2] = v[j][2] * g[j]; scr[kk * 33 + nc + 3] = v[j][3] * g[j]; }
    LDS_WAIT(); asm volatile("" ::: "memory");
    const int c = lane & 7;
#pragma unroll
    for (int j = 0; j < 4; ++j) { const int n = (lane >> 3) + 8 * j; const LAS float* s = scr + (8 * c) * 33 + n;
        v4u o; o.x = cvtpk(s[0 * 33], s[1 * 33]); o.y = cvtpk(s[2 * 33], s[3 * 33]); o.z = cvtpk(s[4 * 33], s[5 * 33]); o.w = cvtpk(s[6 * 33], s[7 * 33]);
        __builtin_nontemporal_store(o, (GAS v4u*)(t.WT + (size_t)(t.n0 + n) * t.K + t.k0 + 8 * c)); }
    LDS_WAIT(); asm volatile("" ::: "memory");
}
__device__ __forceinline__ void row_to_bf16(int lane, const float* xrow, bf16* orow, const float* g, bool normalise, float* rstd_out) {
    const GAS f32x4* xr = (const GAS f32x4*)xrow + lane;
    f32x4 v[4]; float s = 0.f;
#pragma unroll
    for (int j = 0; j < 4; ++j) { v[j] = xr[64 * j]; s += (v[j].x * v[j].x + v[j].y * v[j].y) + (v[j].z * v[j].z + v[j].w * v[j].w); }
    const float rstd = 1.0f / sqrtf(wave_sum(s) * (1.f / D) + NORM_EPS);
    if (rstd_out && lane == 0) *rstd_out = rstd;
    GAS unsigned long long* o8 = (GAS unsigned long long*)orow + lane;
#pragma unroll
    for (int j = 0; j < 4; ++j) { f32x4 w = v[j];
        if (normalise) { const f32x4 gg = *((const f32x4*)g + lane + 64 * j); w = w * rstd * gg; }
        o8[64 * j] = (unsigned long long)pk2(w.x, w.y) | ((unsigned long long)pk2(w.z, w.w) << 32); }
}

struct RefG { const bf16* A; long lda; const bf16* Bt; long ldb; int M, N, K; };
template <class Epi> __device__ __forceinline__ void ref_gemm(Frame& F, const RefG g, const Epi& epi) {
    LAS float* As = (LAS float*)(F.lds); LAS float* Bs = As + 16 * 132;
    const int tx = F.tid & 15, ty = F.tid >> 4;
    const int tm = (g.M + 127) / 128, tn = g.N / 64;
    for (int tile = F.vcu; tile < tm * tn; tile += F.G) {
        const int m0 = (tile / tn) * 128, n0 = (tile % tn) * 64;
        float acc[4][4];
#pragma unroll
        for (int i = 0; i < 4; ++i)
#pragma unroll
            for (int j = 0; j < 4; ++j) acc[i][j] = 0.f;
        for (int k0 = 0; k0 < g.K; k0 += 16) {
            { const int idx = F.tid * 4, r = idx >> 4, kk = idx & 15, row = m0 + r;
#pragma unroll
              for (int j = 0; j < 4; ++j) As[(kk + j) * 132 + r] = row < g.M ? bf2f(g.A[(long)row * g.lda + k0 + kk + j]) : 0.f; }
            { const int idx = F.tid * 2, cc = idx >> 4, kk = idx & 15;
#pragma unroll
              for (int j = 0; j < 2; ++j) Bs[(kk + j) * 68 + cc] = bf2f(g.Bt[(long)(n0 + cc) * g.ldb + k0 + kk + j]); }
            __syncthreads();
#pragma unroll
            for (int kk = 0; kk < 16; ++kk) { float a[4], b[4];
#pragma unroll
                for (int i = 0; i < 4; ++i) a[i] = As[kk * 132 + ty * 4 + i];
#pragma unroll
                for (int j = 0; j < 4; ++j) b[j] = Bs[kk * 68 + tx * 4 + j];
#pragma unroll
                for (int i = 0; i < 4; ++i)
#pragma unroll
                    for (int j = 0; j < 4; ++j) acc[i][j] += a[i] * b[j]; }
            __syncthreads();
        }
#pragma unroll
        for (int i = 0; i < 4; ++i) { const int row = m0 + ty * 4 + i; if (row < g.M) epi(row, n0 + tx * 4, acc[i]); }
    }
}

#define RLF(x, j) __int_as_float(__builtin_amdgcn_readlane(__float_as_int(x), (j)))
namespace attn_body {
typedef ::bf16 bf16;
using bf16x8=__attribute__((ext_vector_type(8)))short;
using s16x4=__attribute__((ext_vector_type(4)))short;
using f32x16=__attribute__((ext_vector_type(16)))float;
using u32x4=__attribute__((ext_vector_type(4)))unsigned;
constexpr int SEQ=::SEQ,D=64,DM=::PROJ_LD,DO=512;
constexpr int NW=8,QBLK=32,QB=QBLK*NW,KVBLK=64,NQB=SEQ/QB;
__device__ __forceinline__ int crow(int r,int hi){return (r&3)+8*(r>>2)+4*hi;}
#define SBAR() __builtin_amdgcn_sched_barrier(0)
__device__ __forceinline__ void cmask(f32x16&p0,f32x16&p1,int jb,int qrel,int hi){
  const float NEG=-INFINITY; int kb=64*jb+4*hi;
  #pragma unroll
  for(int r=0;r<16;++r){int kv=kb+(r&3)+8*(r>>2); if(kv>qrel)p0[r]=NEG; if(kv+32>qrel)p1[r]=NEG;}
}

constexpr int NSLOT=3, SLOTB=8192;
constexpr int LDS_K=0, LDS_V=NSLOT*SLOTB, LDS_WS=2*NSLOT*SLOTB, LDS_OST=LDS_WS+NW*64*4, LDS_BYTES=LDS_OST+NW*4096;
constexpr float C2=0.125f*1.4426950408889634f;
__device__ __forceinline__ void glds16(const void*gsrc,unsigned lds_dst){unsigned keep;
  asm volatile("s_mov_b32 %0, m0\n\ts_mov_b32 m0, %2\n\ts_nop 0\n\tglobal_load_lds_dwordx4 %1, off\n\ts_mov_b32 m0, %0":"=&s"(keep):"v"(gsrc),"s"(lds_dst):"memory");}
__device__ __forceinline__ float max3f(float a,float b,float c){float r;asm("v_max3_f32 %0, %1, %2, %3":"=v"(r):"v"(a),"v"(b),"v"(c));return r;}
__device__ __forceinline__ float max2f(float a,float b){float r;asm("v_max_f32_e32 %0, %1, %2":"=v"(r):"v"(a),"v"(b));return r;}
__device__ __forceinline__ float fadd_s(float a,float b){float r;asm("v_add_f32_e32 %0, %1, %2":"=v"(r):"v"(a),"v"(b));return r;}
__device__ __forceinline__ float fsub_s(float a,float b){float r;asm("v_sub_f32_e32 %0, %1, %2":"=v"(r):"v"(a),"v"(b));return r;}
typedef float f32x2_t __attribute__((ext_vector_type(2))); typedef __bf16 bf16x2_t __attribute__((ext_vector_type(2)));
__device__ __forceinline__ unsigned cvtpk_s(float lo,float hi){f32x2_t v={lo,hi};bf16x2_t b=__builtin_convertvector(v,bf16x2_t);return __builtin_bit_cast(unsigned,b);}
#define WAIT_BAR(N) asm volatile("s_waitcnt vmcnt(" #N ") lgkmcnt(0)\n\ts_barrier":::"memory")

__device__ __forceinline__ void qkt(f32x16&p0,f32x16&p1,const char*Kslot,const bf16x8*qr,int r32,int hi){
  const char*kb=Kslot+hi*1024+r32*16;
  #pragma unroll
  for(int d0=0;d0<4;++d0){
    const bf16x8 b0=*reinterpret_cast<const bf16x8*>(kb+d0*2048);
    const bf16x8 b1=*reinterpret_cast<const bf16x8*>(kb+d0*2048+512);
    if(d0==0){p0=__builtin_amdgcn_mfma_f32_32x32x16_bf16(b0,qr[0],f32x16{},0,0,0);p1=__builtin_amdgcn_mfma_f32_32x32x16_bf16(b1,qr[0],f32x16{},0,0,0);}
    else{p0=__builtin_amdgcn_mfma_f32_32x32x16_bf16(b0,qr[d0],p0,0,0,0);p1=__builtin_amdgcn_mfma_f32_32x32x16_bf16(b1,qr[d0],p1,0,0,0);}}
}
typedef __attribute__((address_space(3))) const char* lds_cptr;
typedef short v4i16_t __attribute__((ext_vector_type(4)));
__device__ __forceinline__ void kload8(bf16x8*kf,lds_cptr kp){
  kf[0]=*(const __attribute__((address_space(3))) bf16x8*)(kp);      kf[1]=*(const __attribute__((address_space(3))) bf16x8*)(kp+512);
  kf[2]=*(const __attribute__((address_space(3))) bf16x8*)(kp+2048); kf[3]=*(const __attribute__((address_space(3))) bf16x8*)(kp+2560);
  kf[4]=*(const __attribute__((address_space(3))) bf16x8*)(kp+4096); kf[5]=*(const __attribute__((address_space(3))) bf16x8*)(kp+4608);
  kf[6]=*(const __attribute__((address_space(3))) bf16x8*)(kp+6144); kf[7]=*(const __attribute__((address_space(3))) bf16x8*)(kp+6656);
}
__device__ __forceinline__ void kload2(bf16x8*kf,lds_cptr kp,int j){ kf[2*j]=*(const __attribute__((address_space(3))) bf16x8*)(kp+j*2048); kf[2*j+1]=*(const __attribute__((address_space(3))) bf16x8*)(kp+j*2048+512); }
__device__ __forceinline__ s16x4 vtr(lds_cptr p){ return __builtin_bit_cast(s16x4,__builtin_amdgcn_ds_read_tr16_b64_v4i16((__attribute__((address_space(3))) v4i16_t*)p)); }
__device__ __forceinline__ float rowmax(const f32x16&p0,const f32x16&p1){
  float a=max3f(p0[0],p0[1],p1[0]),b=max3f(p0[2],p0[3],p1[1]);a=max3f(a,p1[2],p1[3]);
  #pragma unroll
  for(int r=4;r<16;r+=4){a=max3f(a,p0[r],p0[r+1]);b=max3f(b,p0[r+2],p0[r+3]);a=max3f(a,p1[r],p1[r+1]);b=max3f(b,p1[r+2],p1[r+3]);}
  const float m=max2f(a,b);
  auto rr=__builtin_amdgcn_permlane32_swap(__float_as_uint(m),__float_as_uint(m),false,false);
  return max2f(__uint_as_float(rr[0]),__uint_as_float(rr[1]));
}
__device__ __forceinline__ void pv(f32x16*o,int vb,bf16x8 pa0,bf16x8 pa1,bf16x8 pa2,bf16x8 pa3){
  #pragma unroll
  for(int d0=0;d0<2;++d0){s16x4 lo[4],hi[4];
    #pragma unroll
    for(int ks=0;ks<4;++ks){
      asm volatile("ds_read_b64_tr_b16 %0,%1 offset:%c2":"=&v"(lo[ks]):"v"(vb),"i"(d0*4096+ks*1024):"memory");
      asm volatile("ds_read_b64_tr_b16 %0,%1 offset:%c2":"=&v"(hi[ks]):"v"(vb),"i"(d0*4096+ks*1024+512):"memory");}
    asm volatile("s_waitcnt lgkmcnt(0)":::"memory");SBAR();
    #define PK(k) (bf16x8){lo[k][0],lo[k][1],lo[k][2],lo[k][3],hi[k][0],hi[k][1],hi[k][2],hi[k][3]}
    o[d0]=__builtin_amdgcn_mfma_f32_32x32x16_bf16(pa0,PK(0),o[d0],0,0,0);
    o[d0]=__builtin_amdgcn_mfma_f32_32x32x16_bf16(pa1,PK(1),o[d0],0,0,0);
    o[d0]=__builtin_amdgcn_mfma_f32_32x32x16_bf16(pa2,PK(2),o[d0],0,0,0);
    o[d0]=__builtin_amdgcn_mfma_f32_32x32x16_bf16(pa3,PK(3),o[d0],0,0,0);
    #undef PK
  }
}

#ifndef ATTN_STORE16
#define ATTN_STORE16(p,v) (*(u32x4*)(p)=(v))
#endif
template<int THRL> __device__ __forceinline__ void attn_unit(int wave_,int qb,int tstart,const bf16*Qh,const bf16*__restrict__ Kh,const bf16*__restrict__ Vh,bf16*Oh,float beta,char*shm){
  const int lane=lane_id(),r32=lane&31,hi=lane>>5; const int wid=wave_;
  const int q0=qb*QB;
  const bf16*Qw=Qh+(long)(q0+wid*QBLK)*DM;
  const unsigned lds0=(unsigned)(uintptr_t)shm;
  float*wsf=(float*)(shm+LDS_WS)+wid*64;
  const bf16*ksrc=Kh+(long)(lane+tstart*KVBLK)*DM+wid*8;
  const bf16*vsrc=Vh+(long)(16*(wid&3)+(lane>>2)+tstart*KVBLK)*DM+(wid>>2)*32+(lane&3)*8;
  const unsigned kdst=lds0+LDS_K+wid*1024, vdst=lds0+LDS_V+wid*1024;
  #define DMA_K(t,slot) glds16(ksrc+(long)(t)*KVBLK*DM,(unsigned)__builtin_amdgcn_readfirstlane(kdst+(slot)))
  #define DMA_V(t,slot) glds16(vsrc+(long)(t)*KVBLK*DM,(unsigned)__builtin_amdgcn_readfirstlane(vdst+(slot)))
  const int vb0=(int)(lds0+LDS_V)+((lane>>4)&1)*32+(lane&3)*8+(4*hi+((lane&15)>>2))*64;
  const char*Kbase=shm+LDS_K; bf16x8 kf[8];
  const lds_cptr shm3=(lds_cptr)shm; const lds_cptr kp0=shm3+LDS_K+hi*1024+r32*16; const lds_cptr vp0=shm3+LDS_V+((lane>>4)&1)*32+(lane&3)*8+(4*hi+((lane&15)>>2))*64;
  const int NT=(q0+QB)/KVBLK-tstart;
  DMA_K(0,0);DMA_V(0,0);DMA_K(1,SLOTB);
  bf16x8 qr[4];
  #pragma unroll
  for(int d0=0;d0<4;++d0)qr[d0]=*reinterpret_cast<const bf16x8*>(&Qw[(long)r32*DM+d0*16+hi*8]);
  const unsigned one2=(hi==0)?0x3F803F80u:0u; bf16x8 qaug=__builtin_bit_cast(bf16x8,(u32x4){one2,one2,0u,0u});
  #define QAUG_UPDATE() do{ float b_=-mhat; unsigned t1=f2bf(b_); b_-=__uint_as_float(t1<<16); unsigned t2=f2bf(b_); b_-=__uint_as_float(t2<<16); unsigned t3=f2bf(b_); b_-=__uint_as_float(t3<<16); unsigned t4=f2bf(b_); \
      unsigned w2_=t1|(t2<<16), w3_=t3|(t4<<16); if(hi){w2_=0u;w3_=0u;} qaug=__builtin_bit_cast(bf16x8,(u32x4){one2,one2,w2_,w3_}); }while(0)
  #define KAUG(dst,t,half) do{ float b_=beta*(float)(64*((t)+tstart)+32*(half)+r32-q0); unsigned w0_,w1_; \
      { unsigned t1=f2bf(b_); b_-=__uint_as_float(t1<<16); unsigned t2=f2bf(b_); b_-=__uint_as_float(t2<<16); unsigned t3=f2bf(b_); b_-=__uint_as_float(t3<<16); unsigned t4=f2bf(b_); w0_=t1|(t2<<16); w1_=t3|(t4<<16);} \
      if(hi){w0_=0u;w1_=0u;} dst=__builtin_bit_cast(bf16x8,(u32x4){w0_,w1_,one2,one2}); }while(0)
  float mhat=beta*(float)(wid*QBLK+r32),l_reg=0.f;f32x16 o[2];o[0]=f32x16{};o[1]=f32x16{};
  QAUG_UPDATE();
  const int qrel=wid*QBLK+r32;
  #define CMASK(P0,P1,t) do{int jb_=(t)-(NT-4); if(jb_>=0)cmask(P0,P1,jb_,qrel,hi);}while(0)
  bool resc=false;
  #define START(P0,P1) do{ const float rm=rowmax(P0,P1); resc=false; \
    { const float dl=max2f(rm,0.f); mhat=fadd_s(mhat,dl); \
      _Pragma("unroll") for(int r=0;r<16;++r){P0[r]=fsub_s(P0[r],dl);P1[r]=fsub_s(P1[r],dl);} \
      QAUG_UPDATE(); } \
    _Pragma("unroll") for(int r=0;r<16;++r)P0[r]=__builtin_amdgcn_exp2f(P0[r]); }while(0)
  #define RESC() do{ if(resc){ asm volatile("s_waitcnt lgkmcnt(0)":::"memory"); \
      _Pragma("unroll") for(int d_=0;d_<2;++d_) _Pragma("unroll") for(int r=0;r<16;++r)o[d_][r]*=wsf[crow(r,hi)]; } }while(0)
  f32x16 pA0,pA1,pB0,pB1;
  int sl_prev=0,sl_cur=0,sl_next=SLOTB;
  #define ROT() do{sl_prev=sl_cur;sl_cur=sl_next;sl_next=(sl_next==(NSLOT-1)*SLOTB)?0:sl_next+SLOTB;}while(0)
  DMA_K(2,2*SLOTB);
  WAIT_BAR(3);
  qkt(pA0,pA1,Kbase,qr,r32,hi);
  { bf16x8 ka0,ka1; KAUG(ka0,0,0); KAUG(ka1,0,1); pA0=__builtin_amdgcn_mfma_f32_32x32x16_bf16(ka0,qaug,pA0,0,0,0); pA1=__builtin_amdgcn_mfma_f32_32x32x16_bf16(ka1,qaug,pA1,0,0,0); }
  asm volatile("s_nop 15\n\ts_nop 7":"+v"(pA0),"+v"(pA1));CMASK(pA0,pA1,0);
  START(pA0,pA1);
  _Pragma("unroll") for(int r=0;r<16;++r)pA1[r]=__builtin_amdgcn_exp2f(pA1[r]);
  WAIT_BAR(0);
  DMA_K(3,0);DMA_V(1,SLOTB);
  ROT();
  kload8(kf,kp0+sl_cur);
  WAIT_BAR(2);
  s16x4 vlo[8],vhi[8]; u32x4 pw0,pw1,pw2,pw3;
  #define PKW(P,B) cvtpk_s(P[B],P[B+1])
  #define PAF(k) __builtin_bit_cast(bf16x8,pw##k)
  #define VFR(i) (bf16x8){vlo[i][0],vlo[i][1],vlo[i][2],vlo[i][3],vhi[i][0],vhi[i][1],vhi[i][2],vhi[i][3]}
  #define PIN(x) asm volatile("":"+v"(x))
  #define MX3(a,b,c) __builtin_fmaxf(__builtin_fmaxf((a),(b)),(c))
  #define GAPA(MF,A0,A1,A2,A3,W0,W1,PW) do{ MF; sacc+=A0; sacc+=A1; sacc+=A2; sacc+=A3; PIN(sacc); W0; W1; PIN(PW); SBAR(); }while(0)
  #define EX(v) __builtin_amdgcn_exp2f(v)
  #define GAPB(MF,X,B) do{ MF; X[B]=EX(X[B]); X[B+1]=EX(X[B+1]); X[B+2]=EX(X[B+2]); X[B+3]=EX(X[B+3]); PIN(X); SBAR(); }while(0)
  #define VRD(i) do{ vlo[i]=vtr(vp_+(((i)>>2)*4096+((i)&3)*1024)); vhi[i]=vtr(vp_+(((i)>>2)*4096+((i)&3)*1024+512)); }while(0)
  #define KRD(G,j) do{ if(G){ kload2(kf,kp0+sl_next,j); SBAR(); } }while(0)
  #define STEP(C0,C1,P0,P1,t,GK,GV,GL) do{ SBAR(); \
    const lds_cptr vp_=vp0+sl_prev; \
    VRD(0); SBAR(); float sacc=(P0[0]+P0[1]); \
    GAPA(C0=__builtin_amdgcn_mfma_f32_32x32x16_bf16(kf[0],qr[0],f32x16{},0,0,0), P0[2],P0[3],P0[4],P0[5],     pw0[0]=PKW(P0,0), pw0[1]=PKW(P0,2), pw0); \
    VRD(4); SBAR(); GAPA(C1=__builtin_amdgcn_mfma_f32_32x32x16_bf16(kf[1],qr[0],f32x16{},0,0,0), P0[6],P0[7],P0[8],P0[9],     pw0[2]=PKW(P0,4), pw0[3]=PKW(P0,6), pw0); \
    VRD(1); SBAR(); GAPA(C0=__builtin_amdgcn_mfma_f32_32x32x16_bf16(kf[2],qr[1],C0,0,0,0),   P0[10],P0[11],P0[12],P0[13], pw1[0]=PKW(P0,8), pw1[1]=PKW(P0,10), pw1); \
    VRD(5); SBAR(); GAPA(C1=__builtin_amdgcn_mfma_f32_32x32x16_bf16(kf[3],qr[1],C1,0,0,0),   P0[14],P0[15],P1[0],P1[1],   pw1[2]=PKW(P0,12),pw1[3]=PKW(P0,14), pw1); \
    VRD(2); SBAR(); GAPA(C0=__builtin_amdgcn_mfma_f32_32x32x16_bf16(kf[4],qr[2],C0,0,0,0),   P1[2],P1[3],P1[4],P1[5],     pw2[0]=PKW(P1,0), pw2[1]=PKW(P1,2), pw2); \
    VRD(6); SBAR(); GAPA(C1=__builtin_amdgcn_mfma_f32_32x32x16_bf16(kf[5],qr[2],C1,0,0,0),   P1[6],P1[7],P1[8],P1[9],     pw2[2]=PKW(P1,4), pw2[3]=PKW(P1,6), pw2); \
    VRD(3); SBAR(); GAPA(C0=__builtin_amdgcn_mfma_f32_32x32x16_bf16(kf[6],qr[3],C0,0,0,0),   P1[10],P1[11],P1[12],P1[13], pw3[0]=PKW(P1,8), pw3[1]=PKW(P1,10), pw3); \
    VRD(7); SBAR(); GAPA(C1=__builtin_amdgcn_mfma_f32_32x32x16_bf16(kf[7],qr[3],C1,0,0,0),   P1[14],P1[15],0.f,0.f,       pw3[2]=PKW(P1,12),pw3[3]=PKW(P1,14), pw3); \
    { bf16x8 ka0_,ka1_; KAUG(ka0_,t,0); KAUG(ka1_,t,1); C0=__builtin_amdgcn_mfma_f32_32x32x16_bf16(ka0_,qaug,C0,0,0,0); C1=__builtin_amdgcn_mfma_f32_32x32x16_bf16(ka1_,qaug,C1,0,0,0); } \
    l_reg+=sacc; \
    if(GK){DMA_K((t)+3,sl_cur);} if(GV){DMA_V((t)+1,sl_next);} \
    CMASK(C0,C1,t); \
    { float a=MX3(C0[0],C0[1],C1[0]),b=MX3(C0[2],C0[3],C1[1]); a=MX3(a,C1[2],C1[3]); \
      _Pragma("unroll") for(int r=4;r<16;r+=4){a=MX3(a,C0[r],C0[r+1]);b=MX3(b,C0[r+2],C0[r+3]);a=MX3(a,C1[r],C1[r+1]);b=MX3(b,C1[r+2],C1[r+3]);} \
      float rm=__builtin_fmaxf(a,b); { auto rr=__builtin_amdgcn_permlane32_swap(__float_as_uint(rm),__float_as_uint(rm),false,false); rm=__builtin_fmaxf(__uint_as_float(rr[0]),__uint_as_float(rr[1])); } \
      resc=false; \
      if(__builtin_expect(__any(rm>(float)THRL),0)){ const float dl=__builtin_fmaxf(rm,0.f); mhat+=dl; \
        _Pragma("unroll") for(int r=0;r<16;++r){C0[r]-=dl;C1[r]-=dl;} \
        QAUG_UPDATE(); \
        const float f=__builtin_amdgcn_exp2f(-dl); l_reg*=f; if(hi==0)wsf[r32]=f; resc=true; } } \
    SBAR(); \
    GAPB(o[0]=__builtin_amdgcn_mfma_f32_32x32x16_bf16(PAF(0),VFR(0),o[0],0,0,0), C0,0); \
    GAPB(o[1]=__builtin_amdgcn_mfma_f32_32x32x16_bf16(PAF(0),VFR(4),o[1],0,0,0), C0,4); \
    KRD(GL,0); GAPB(o[0]=__builtin_amdgcn_mfma_f32_32x32x16_bf16(PAF(1),VFR(1),o[0],0,0,0), C0,8); \
    KRD(GL,1); GAPB(o[1]=__builtin_amdgcn_mfma_f32_32x32x16_bf16(PAF(1),VFR(5),o[1],0,0,0), C0,12); \
    KRD(GL,2); GAPB(o[0]=__builtin_amdgcn_mfma_f32_32x32x16_bf16(PAF(2),VFR(2),o[0],0,0,0), C1,0); \
    KRD(GL,3); GAPB(o[1]=__builtin_amdgcn_mfma_f32_32x32x16_bf16(PAF(2),VFR(6),o[1],0,0,0), C1,4); \
    GAPB(o[0]=__builtin_amdgcn_mfma_f32_32x32x16_bf16(PAF(3),VFR(3),o[0],0,0,0), C1,8); \
    GAPB(o[1]=__builtin_amdgcn_mfma_f32_32x32x16_bf16(PAF(3),VFR(7),o[1],0,0,0), C1,12); \
    }while(0)
  int t=1;
  #undef CMASK
  #define CMASK(P0,P1,t) do{}while(0)
  for(;t+5<NT;t+=2){
    STEP(pB0,pB1,pA0,pA1,t,true,true,true);     WAIT_BAR(2); RESC(); ROT();
    STEP(pA0,pA1,pB0,pB1,t+1,true,true,true);   WAIT_BAR(2); RESC(); ROT();
  }
  #undef CMASK
  #define CMASK(P0,P1,t) do{int jb_=(t)-(NT-4); if(jb_>=0)cmask(P0,P1,jb_,qrel,hi);}while(0)
  #define ENDW(tt) do{ if((tt)+3<NT){WAIT_BAR(2);} else if((tt)+2<NT){WAIT_BAR(1);} else {WAIT_BAR(0);} }while(0)
  for(;t+1<NT;t+=2){
    STEP(pB0,pB1,pA0,pA1,t,(t+3<NT),(t+1<NT),(t+1<NT));       ENDW(t);   RESC(); ROT();
    STEP(pA0,pA1,pB0,pB1,t+1,(t+4<NT),(t+2<NT),(t+2<NT));     ENDW(t+1); RESC(); ROT();
  }
  STEP(pB0,pB1,pA0,pA1,NT-1,false,false,false); RESC();
  { float sacc=pB0[0]+pB0[1]; _Pragma("unroll") for(int r=2;r<16;++r)sacc+=pB0[r]; _Pragma("unroll") for(int r=0;r<16;++r)sacc+=pB1[r]; l_reg+=sacc;
    pw0=(u32x4){PKW(pB0,0),PKW(pB0,2),PKW(pB0,4),PKW(pB0,6)};pw1=(u32x4){PKW(pB0,8),PKW(pB0,10),PKW(pB0,12),PKW(pB0,14)};pw2=(u32x4){PKW(pB1,0),PKW(pB1,2),PKW(pB1,4),PKW(pB1,6)};pw3=(u32x4){PKW(pB1,8),PKW(pB1,10),PKW(pB1,12),PKW(pB1,14)};
    SBAR(); pv(o,vb0+sl_cur,PAF(0),PAF(1),PAF(2),PAF(3)); }
  #undef PKW
  #undef PAF
  #undef VFR
  #undef PIN
  #undef MX3
  #undef GAPA
  #undef GAPB
  #undef EX
  #undef VRD
  #undef KRD
  #undef STEP
  #undef ENDW
  {auto rr=__builtin_amdgcn_permlane32_swap(__float_as_uint(l_reg),__float_as_uint(l_reg),false,false);l_reg=__uint_as_float(rr[0])+__uint_as_float(rr[1]);}
  if(hi==0)wsf[32+r32]=l_reg;asm volatile("s_waitcnt lgkmcnt(0)":::"memory");
  float rli[16];
  #pragma unroll
  for(int r=0;r<16;++r)rli[r]=__builtin_amdgcn_rcpf(wsf[32+crow(r,hi)]);
  bf16*Ow=Oh+(long)(q0+wid*QBLK)*DO;
  { bf16*stg=(bf16*)(shm+LDS_OST)+wid*2048;
    #pragma unroll
    for(int r=0;r<16;++r){const int orow=crow(r,hi);
      #pragma unroll
      for(int d0=0;d0<2;++d0)stg[orow*64+d0*32+r32]=(bf16)f2bf(o[d0][r]*rli[r]);}
    asm volatile("s_waitcnt lgkmcnt(0)":::"memory");
    #pragma unroll
    for(int i=0;i<4;++i){const int row=i*8+(lane>>3),ch=lane&7; const u32x4 v=*(const u32x4*)(stg+row*64+ch*8); ATTN_STORE16(Ow+(long)row*DO+ch*8,v);} }
  asm volatile("s_waitcnt lgkmcnt(0)\n\ts_barrier":::"memory");
  #undef KAUG
  #undef QAUG_UPDATE
  #undef DMA_K
  #undef DMA_V
  #undef CMASK
  #undef START
  #undef RESC
  #undef ROT
}
constexpr int ATTN_LDS_BYTES=LDS_BYTES;
#undef SBAR
#undef WAIT_BAR
}
namespace rwkv {
typedef float f32x16 __attribute__((ext_vector_type(16)));
constexpr int L = 32, NCH = SEQ / L;
constexpr int AR_STRIDE = 144, TI_STRIDE = 64;
constexpr int O_A0 = 0, O_A1 = 4608, O_BK = 9216, O_MAK = 9216, O_MRB = 11264, O_MRK = 13312, O_W = 15360, O_AT = 15360, O_UT = 15360, O_VT = 0, O_BT = 4608, O_KT = 9216;
constexpr int WAVE_LDS = 19456;
__device__ __forceinline__ int crow(int r, int h) { return (r & 3) + 8 * (r >> 2) + 4 * h; }
__device__ __forceinline__ unsigned pkbf(float lo, float hi) { return cvtpk(lo, hi); }
__device__ __forceinline__ unsigned short bf1(float x) { return (unsigned short)cvtpk(x, 0.f); }
__device__ __forceinline__ bf16x8 frag(const LAS unsigned char* img, int stride, int row, int s, int h) { return *(const LAS bf16x8*)(img + row * stride + (16 * s + 8 * h) * 2); }
__device__ __forceinline__ bf16x8 packfrag(const f32x16& a, int s) { v4u w; w.x = pkbf(a[8 * s], a[8 * s + 1]); w.y = pkbf(a[8 * s + 2], a[8 * s + 3]); w.z = pkbf(a[8 * s + 4], a[8 * s + 5]); w.w = pkbf(a[8 * s + 6], a[8 * s + 7]); return __builtin_bit_cast(bf16x8, w); }
#define RWKV_MFMA(a, b, c) __builtin_amdgcn_mfma_f32_32x32x16_bf16(a, b, c, 0, 0, 0)
#define LDS_FENCE() asm volatile("s_waitcnt lgkmcnt(0)" ::: "memory")

struct ChunkBufs { unsigned char* GF; unsigned char* HT; unsigned char* RF; unsigned char* Y0; };

__device__ __forceinline__ void stage1_chunk(LAS unsigned char* lw, const ChunkBufs& cb, int ch, const bf16* Rr, const float* Wr, const bf16* Kr, const bf16* Vr, const bf16* KKr, const bf16* KKAr, int lane) {
    asm volatile("" : "+v"(lane));
    const int bh = ch / NCH, cidx = ch % NCH, b = bh >> 3, hd = bh & 7; const int r32 = lane & 31, h = lane >> 5;
    const size_t row0 = (size_t)b * SEQ + (size_t)cidx * L; const int col = hd * 64 + lane;
    float Xa[32]; unsigned vpk[16], bpk[16], kpk[16];
    float g = 0.f, eg = 1.f;
    float ldv[2][8][6];
#define S1_LOAD(buf, t0_) do { _Pragma("unroll") for (int u = 0; u < 8; ++u) { const size_t o = (row0 + (t0_) + u) * C + col; \
        ldv[buf][u][0] = bf2f(Rr[o]); ldv[buf][u][1] = Wr[o]; ldv[buf][u][2] = bf2f(Kr[o]); ldv[buf][u][3] = bf2f(KKr[o]); ldv[buf][u][4] = bf2f(KKAr[o]); ldv[buf][u][5] = bf2f(Vr[o]); } } while (0)
    S1_LOAD(0, 0);
#pragma unroll
    for (int tg = 0; tg < 4; ++tg) {
        asm volatile("" ::: "memory");
        if (tg < 3) { if (tg & 1) S1_LOAD(0, 8 * tg + 8); else S1_LOAD(1, 8 * tg + 8); }
#pragma unroll
        for (int u2 = 0; u2 < 8; u2 += 2) { const int t = 8 * tg + u2;
            float ah[2], rh[2], bh_[2], kh[2], vv[2];
#pragma unroll
            for (int u = 0; u < 2; ++u) { const float* lv = ldv[tg & 1][u2 + u];
                const float r = lv[0], w = lv[1], k = lv[2], kk = lv[3], kka = lv[4]; vv[u] = lv[5];
                const float egp = eg; g += w  ; eg = __expf(g); const float einv = __builtin_amdgcn_rcpf(eg);
                ah[u] = -kk * egp; rh[u] = r * eg; bh_[u] = kka * einv; kh[u] = k * einv; Xa[t + u] = ah[u]; }
            const unsigned pa = pkbf(ah[0], ah[1]), pr = pkbf(rh[0], rh[1]), pb = pkbf(bh_[0], bh_[1]), pk = pkbf(kh[0], kh[1]);
            vpk[t >> 1] = pkbf(vv[0], vv[1]); bpk[t >> 1] = pb; kpk[t >> 1] = pk;
            *(LAS unsigned short*)(lw + O_A0 + t * AR_STRIDE + lane * 2) = (unsigned short)pa; *(LAS unsigned short*)(lw + O_A0 + (t + 1) * AR_STRIDE + lane * 2) = (unsigned short)(pa >> 16);
            *(LAS unsigned short*)(lw + O_A1 + t * AR_STRIDE + lane * 2) = (unsigned short)pr; *(LAS unsigned short*)(lw + O_A1 + (t + 1) * AR_STRIDE + lane * 2) = (unsigned short)(pr >> 16);
            *(LAS unsigned short*)(lw + O_BK + t * AR_STRIDE + lane * 2) = (unsigned short)pb; *(LAS unsigned short*)(lw + O_BK + (t + 1) * AR_STRIDE + lane * 2) = (unsigned short)(pb >> 16);
            *(LAS unsigned short*)(lw + O_BK + (32 + t) * AR_STRIDE + lane * 2) = (unsigned short)pk; *(LAS unsigned short*)(lw + O_BK + (33 + t) * AR_STRIDE + lane * 2) = (unsigned short)(pk >> 16);
        }
    }
#undef S1_LOAD
    const float egL = eg;
    LDS_FENCE();
    f32x16 mab = {}, mak = {}, mrb = {}, mrk = {};
#pragma unroll
    for (int s = 0; s < 4; ++s) {
        const bf16x8 fa = frag(lw + O_A0, AR_STRIDE, r32, s, h), fr = frag(lw + O_A1, AR_STRIDE, r32, s, h);
        const bf16x8 fb = frag(lw + O_BK, AR_STRIDE, r32, s, h), fk = frag(lw + O_BK, AR_STRIDE, 32 + r32, s, h);
        mab = RWKV_MFMA(fa, fb, mab); mak = RWKV_MFMA(fa, fk, mak); mrb = RWKV_MFMA(fr, fb, mrb); mrk = RWKV_MFMA(fr, fk, mrk);
    }
    const float fd = (float)(r32 - 4 * h);
#pragma unroll
    for (int r = 0; r < 16; ++r) { const float dtj = (float)crow(r, 0) - fd; const float fs = fminf(fmaxf(dtj, 0.f), 1.f), fi = fminf(fmaxf(dtj + 1.f, 0.f), 1.f);
        mab[r] *= fs; mak[r] *= fs; mrb[r] *= fi; mrk[r] *= fi;
    }
    LDS_FENCE();
#pragma unroll
    for (int r = 0; r < 16; ++r) { const int t = crow(r, h);
        *(LAS unsigned short*)(lw + O_MAK + t * TI_STRIDE + r32 * 2) = bf1(mak[r]);
        *(LAS unsigned short*)(lw + O_MRB + t * TI_STRIDE + r32 * 2) = bf1(mrb[r]);
        *(LAS unsigned short*)(lw + O_MRK + t * TI_STRIDE + r32 * 2) = bf1(mrk[r]);
    }
#pragma unroll
    for (int q = 0; q < 4; ++q) *(LAS v4u*)(lw + O_VT + lane * TI_STRIDE + 16 * q) = (v4u){vpk[4 * q], vpk[4 * q + 1], vpk[4 * q + 2], vpk[4 * q + 3]};
    LDS_FENCE();
    float Xu[32];
#pragma unroll
    for (int ct = 0; ct < 2; ++ct) {
        f32x16 w0 = {};
#pragma unroll
        for (int s = 0; s < 2; ++s) w0 = RWKV_MFMA(frag(lw + O_MAK, TI_STRIDE, r32, s, h), frag(lw + O_VT, TI_STRIDE, ct * 32 + r32, s, h), w0);
#pragma unroll
        for (int r = 0; r < 16; ++r) *(LAS float*)(lw + O_W + crow(r, h) * 128 + r32 * 4) = w0[r];
        LDS_FENCE();
        if (h == ct) {
#pragma unroll
            for (int t = 0; t < L; ++t) Xu[t] = *(const LAS float*)(lw + O_W + t * 128 + r32 * 4); }
        LDS_FENCE();
    }
#pragma unroll
    for (int t = 1; t < L; ++t) {
        const int rt = (t & 3) + 4 * (t >> 3), ht = (t >> 2) & 1;
        float xa = Xa[t], xu = Xu[t];
#pragma unroll
        for (int j = 0; j < t; ++j) { const float n = __int_as_float(__builtin_amdgcn_readlane(__float_as_int(mab[rt]), j + 32 * ht)); xa += n * Xa[j]; xu += n * Xu[j]; }
        Xa[t] = xa; Xu[t] = xu;
    }
#pragma unroll
    for (int q = 0; q < 4; ++q) *(LAS v4u*)(lw + O_AT + lane * TI_STRIDE + 16 * q) = (v4u){pkbf(Xa[8 * q], Xa[8 * q + 1]), pkbf(Xa[8 * q + 2], Xa[8 * q + 3]), pkbf(Xa[8 * q + 4], Xa[8 * q + 5]), pkbf(Xa[8 * q + 6], Xa[8 * q + 7])};
    LDS_FENCE();
#pragma unroll
    for (int rt = 0; rt < 2; ++rt) { f32x16 a;
#pragma unroll
        for (int r = 0; r < 16; ++r) a[r] = __uint_as_float((unsigned)*(const LAS unsigned short*)(lw + O_A1 + r32 * AR_STRIDE + (rt * 32 + crow(r, h)) * 2) << 16);
#pragma unroll
        for (int s = 0; s < 2; ++s) a = RWKV_MFMA(frag(lw + O_AT, TI_STRIDE, rt * 32 + r32, s, h), frag(lw + O_MRB, TI_STRIDE, r32, s, h), a);
#pragma unroll
        for (int s = 0; s < 2; ++s) *(bf16x8*)(cb.RF + (size_t)ch * 4096 + ((rt * 2 + s) * 64 + lane) * 16) = packfrag(a, s);
    }
    LDS_FENCE();
#pragma unroll
    for (int q = 0; q < 4; ++q) { v4u wb;
#pragma unroll
        for (int e = 0; e < 4; ++e) { const unsigned pb = bpk[4 * q + e]; wb[e] = pkbf(__uint_as_float(pb << 16) * egL, __uint_as_float(pb & 0xffff0000u) * egL); }
        *(LAS v4u*)(lw + O_BT + lane * TI_STRIDE + 16 * q) = wb; }
    LDS_FENCE();
#pragma unroll
    for (int ct = 0; ct < 2; ++ct) { const float egc = __shfl(egL, ct * 32 + r32);
#pragma unroll
        for (int rt = 0; rt < 2; ++rt) { f32x16 a = {};
#pragma unroll
            for (int s = 0; s < 2; ++s) a = RWKV_MFMA(frag(lw + O_AT, TI_STRIDE, rt * 32 + r32, s, h), frag(lw + O_BT, TI_STRIDE, ct * 32 + r32, s, h), a);
            if (rt == ct) {
#pragma unroll
                for (int r = 0; r < 16; ++r) { const float dtj = (float)crow(r, 0) - fd; a[r] += egc * (fminf(fmaxf(dtj + 1.f, 0.f), 1.f) - fminf(fmaxf(dtj, 0.f), 1.f)); } }
#pragma unroll
            for (int s = 0; s < 2; ++s) *(bf16x8*)(cb.GF + (size_t)ch * 8192 + (((ct * 2 + rt) * 2 + s) * 64 + lane) * 16) = packfrag(a, s);
        } }
    LDS_FENCE();
#pragma unroll
    for (int q = 0; q < 4; ++q) *(LAS v4u*)(lw + O_UT + lane * TI_STRIDE + 16 * q) = (v4u){pkbf(Xu[8 * q], Xu[8 * q + 1]), pkbf(Xu[8 * q + 2], Xu[8 * q + 3]), pkbf(Xu[8 * q + 4], Xu[8 * q + 5]), pkbf(Xu[8 * q + 6], Xu[8 * q + 7])};
    LDS_FENCE();
#pragma unroll
    for (int ct = 0; ct < 2; ++ct) { f32x16 a = {};
#pragma unroll
        for (int s = 0; s < 2; ++s) { a = RWKV_MFMA(frag(lw + O_MRB, TI_STRIDE, r32, s, h), frag(lw + O_UT, TI_STRIDE, ct * 32 + r32, s, h), a);
                                      a = RWKV_MFMA(frag(lw + O_MRK, TI_STRIDE, r32, s, h), frag(lw + O_VT, TI_STRIDE, ct * 32 + r32, s, h), a); }
        unsigned char* dst = cb.Y0 + (size_t)ch * 4096 + (ct * 64 + lane) * 32;
#pragma unroll
        for (int q = 0; q < 2; ++q) *(v4u*)(dst + 16 * q) = (v4u){pkbf(a[8 * q], a[8 * q + 1]), pkbf(a[8 * q + 2], a[8 * q + 3]), pkbf(a[8 * q + 4], a[8 * q + 5]), pkbf(a[8 * q + 6], a[8 * q + 7])};
    }
    LDS_FENCE();
#pragma unroll
    for (int q = 0; q < 4; ++q) { v4u wk;
#pragma unroll
        for (int e = 0; e < 4; ++e) { const unsigned pk = kpk[4 * q + e]; wk[e] = pkbf(__uint_as_float(pk << 16) * egL, __uint_as_float(pk & 0xffff0000u) * egL); }
        *(LAS v4u*)(lw + O_KT + lane * TI_STRIDE + 16 * q) = wk; }
    LDS_FENCE();
#pragma unroll
    for (int rt = 0; rt < 2; ++rt)
#pragma unroll
        for (int ct = 0; ct < 2; ++ct) { f32x16 a = {};
#pragma unroll
            for (int s = 0; s < 2; ++s) { a = RWKV_MFMA(frag(lw + O_BT, TI_STRIDE, rt * 32 + r32, s, h), frag(lw + O_UT, TI_STRIDE, ct * 32 + r32, s, h), a);
                                          a = RWKV_MFMA(frag(lw + O_KT, TI_STRIDE, rt * 32 + r32, s, h), frag(lw + O_VT, TI_STRIDE, ct * 32 + r32, s, h), a); }
            unsigned char* dst = cb.HT + (size_t)ch * 8192 + ((rt * 2 + ct) * 64 + lane) * 32;
#pragma unroll
            for (int q = 0; q < 2; ++q) *(v4u*)(dst + 16 * q) = (v4u){pkbf(a[8 * q], a[8 * q + 1]), pkbf(a[8 * q + 2], a[8 * q + 3]), pkbf(a[8 * q + 4], a[8 * q + 5]), pkbf(a[8 * q + 6], a[8 * q + 7])};
        }
    LDS_FENCE();
}

struct S2Ops { bf16x8 G[2][2][2], R[2][2]; f32x16 n0, n1; const unsigned char* yp; };
__device__ __forceinline__ void s2_load(S2Ops& o, const ChunkBufs& cb, size_t ch, int iblk, int lane) {
    const unsigned char* g0 = cb.GF + ch * 8192 + lane * 16; const unsigned char* g1 = g0 + 4096; const unsigned char* rp = cb.RF + ch * 4096 + lane * 16;
    const unsigned char* h0 = cb.HT + ch * 8192 + (iblk * 64 + lane) * 32; const unsigned char* h1 = h0 + 4096; const unsigned char* yp = cb.Y0 + ch * 4096 + (iblk * 64 + lane) * 32;
    o.yp = yp;
#pragma unroll
    for (int bq = 0; bq < 2; ++bq)
#pragma unroll
        for (int s = 0; s < 2; ++s) { o.G[0][bq][s] = *(const bf16x8*)(g0 + (bq * 2 + s) * 1024); o.G[1][bq][s] = *(const bf16x8*)(g1 + (bq * 2 + s) * 1024); o.R[bq][s] = *(const bf16x8*)(rp + (bq * 2 + s) * 1024); }
#pragma unroll
    for (int q = 0; q < 2; ++q) { const v4u v0 = *(const v4u*)(h0 + 16 * q), v1 = *(const v4u*)(h1 + 16 * q);
#pragma unroll
        for (int e = 0; e < 4; ++e) { o.n0[8 * q + 2 * e] = __uint_as_float(v0[e] << 16); o.n0[8 * q + 2 * e + 1] = __uint_as_float(v0[e] & 0xffff0000u); o.n1[8 * q + 2 * e] = __uint_as_float(v1[e] << 16); o.n1[8 * q + 2 * e + 1] = __uint_as_float(v1[e] & 0xffff0000u); } }
}
__device__ __forceinline__ void s2_step(S2Ops& o, const bf16x8 (&sf)[2][2], float* yo, int h) {
    f32x16 y;
#pragma unroll
    for (int q = 0; q < 2; ++q) { const v4u vy = *(const v4u*)(o.yp + 16 * q);
#pragma unroll
        for (int e = 0; e < 4; ++e) { y[8 * q + 2 * e] = __uint_as_float(vy[e] << 16); y[8 * q + 2 * e + 1] = __uint_as_float(vy[e] & 0xffff0000u); } }
#pragma unroll
    for (int bq = 0; bq < 2; ++bq)
#pragma unroll
        for (int s = 0; s < 2; ++s) { o.n0 = RWKV_MFMA(o.G[0][bq][s], sf[bq][s], o.n0); o.n1 = RWKV_MFMA(o.G[1][bq][s], sf[bq][s], o.n1); }
#pragma unroll
    for (int bq = 0; bq < 2; ++bq)
#pragma unroll
        for (int s = 0; s < 2; ++s) y = RWKV_MFMA(o.R[bq][s], sf[bq][s], y);
#pragma unroll
    for (int r = 0; r < 16; ++r) yo[(size_t)crow(r, h) * C] = y[r];
}
__device__ __forceinline__ void stage2(const ChunkBufs& cb, int bh, int iblk, float* YRAW, int lane) {
    const int r32 = lane & 31, h = lane >> 5, b = bh >> 3, hd = bh & 7;
    float* yo = YRAW + (size_t)b * SEQ * C + hd * 64 + iblk * 32 + r32;
    const size_t ch0 = (size_t)bh * NCH;
    S2Ops A, B; A.n0 = f32x16{}; A.n1 = f32x16{};
    s2_load(B, cb, ch0, iblk, lane);
#pragma unroll 1
    for (int c = 0; c < NCH; c += 2) {
        bf16x8 sf[2][2];
#pragma unroll
        for (int s = 0; s < 2; ++s) { sf[0][s] = packfrag(A.n0, s); sf[1][s] = packfrag(A.n1, s); }
        s2_load(A, cb, ch0 + c + 1, iblk, lane);
        s2_step(B, sf, yo + (size_t)c * L * C, h);
#pragma unroll
        for (int s = 0; s < 2; ++s) { sf[0][s] = packfrag(B.n0, s); sf[1][s] = packfrag(B.n1, s); }
        if (c + 2 < NCH) s2_load(B, cb, ch0 + c + 2, iblk, lane);
        s2_step(A, sf, yo + (size_t)(c + 1) * L * C, h);
    }
}
#undef RWKV_MFMA
#undef LDS_FENCE
}
#ifndef MK_REPEAT_PHASE
#define MK_REPEAT_PHASE -1
#endif
#ifndef ATTN_SKIP
#define ATTN_SKIP 1
#endif
#ifndef CONV_EIGHTHS
#define CONV_EIGHTHS 2
#endif
#ifndef OPT_GEMM
#define OPT_GEMM 1
#endif
#ifndef OPT_ATTN
#define OPT_ATTN 1
#endif
#ifndef OPT_PREP
#define OPT_PREP 1
#endif
#ifndef OPT_ROUTER
#define OPT_ROUTER 1
#endif

__global__ void __launch_bounds__(NTHR, 2) mk_fwd(Args args) {
    extern __shared__ __attribute__((aligned(16))) unsigned char lds[];
    Frame F;
    F.lds = (LAS unsigned char*)lds;
    F.MISC = (volatile LAS unsigned*)(F.lds + MISC_OFF);
    F.wave = __builtin_amdgcn_readfirstlane((int)threadIdx.x >> 6); F.lane = lane_id(); F.tid = F.wave * 64 + F.lane;
    F.G = gridDim.x; { const int bx = blockIdx.x; F.vcu = (F.G % 8 == 0) ? (bx % 8) * (F.G / 8) + bx / 8 : bx; }
    F.ctl = (gu32*)(args.ws + WS_CTL);
    for (int u = F.tid; u < (LDS_BYTES - LDSCTL_OFF) / 4; u += NTHR) ((LAS unsigned*)(F.lds + LDSCTL_OFF))[u] = 0u;
    __syncthreads();
    XcdBarrier bar = xcd_barrier_post((unsigned*)(F.ctl + CW_BAR) + args.li * 4096, F.MISC + 8, F.wave);
    const int lo = args.ph_lo, hi = args.ph_hi;
#define IN(k) (lo <= (k) && (k) < hi)
#define SEAM(k) do { if (IN(k) && IN((k) + 1)) xcd_barrier(bar, F.wave); } while (0)
    const __attribute__((address_space(4))) unsigned char* ka = (const __attribute__((address_space(4))) unsigned char*)__builtin_amdgcn_kernarg_segment_ptr();
#define KIN(i) ((const float*)(((const GAS float* const __attribute__((address_space(4)))*)ka)[i]))
#define KOUT ((float*)(((GAS float* const __attribute__((address_space(4)))*)ka)[34]))
    GAS unsigned char* ws = (GAS unsigned char*)args.ws;
    const float* x = KIN(0);
#define XB ((bf16*)(ws + WS_XB))
#define RSTD0 ((float*)(ws + WS_RSTD0))
#define WIN_T ((bf16*)(ws + WS_WIN_T))
#define WOUT_T ((bf16*)(ws + WS_WOUT_T))
#define WCQ_N ((bf16*)(ws + WS_WCQ_N))
#define WCKV_T ((bf16*)(ws + WS_WCKV_T))
#define WCO_T ((bf16*)(ws + WS_WCO_T))
#define MN ((bf16*)(ws + WS_MN))
#define MKV ((bf16*)(ws + WS_MKV))
#define WQK_T ((bf16*)(ws + WS_WQK_T))
#define WVO_T ((bf16*)(ws + WS_WVO_T))
#define WL ((bf16*)(ws + WS_WL))
#define W1_T ((bf16*)(ws + WS_W1_T))
#define W2_T ((bf16*)(ws + WS_W2_T))
#define PROJ ((bf16*)(ws + WS_PROJ))
#define Y ((bf16*)(ws + WS_Y))
#define X1 ((float*)(ws + WS_X1))
#define X1B ((bf16*)(ws + WS_X1B))
#define P ((bf16*)(ws + WS_P))
#define X2 ((float*)(ws + WS_X2))
#define X2B ((bf16*)(ws + WS_X2B))
#define SS1 ((float*)(ws + WS_CTL + CTL_SS1))
#define SS2 ((float*)(ws + WS_CTL + CTL_SS2))
#define CNT ((int*)(ws + WS_CTL + CTL_CNT))
#define GATE ((float*)(ws + WS_GATE))
#define ROWOF ((int*)(ws + WS_ROWOF))
#define TOKOF ((int*)(ws + WS_TOKOF))
#define LIST ((int*)(ws + WS_LIST))
#define WCNT ((int*)(ws + WS_LIST))
#define SELR ((int*)(ws + WS_LIST + MiB))
#define RS2 ((float*)(ws + WS_RS2))
#define RG ((float*)(ws + WS_RG))
#define XG ((bf16*)(ws + WS_XG))
#define ACT ((bf16*)(ws + WS_ACT))
#define YE ((bf16*)(ws + WS_XG))
#define RS ((bf16*)(ws + WS_RS))
#define LWA ((float*)(ws + WS_LW))
#define GG ((bf16*)(ws + WS_GG))
#define OC ((bf16*)(ws + WS_OC))
#define TMP ((float*)(ws + WS_TMP))

    if (IN(0)) {
        refresh(F); asm volatile("" : "+s"(ws), "+s"(ka));
        LAS float* scr = (LAS float*)(F.lds + RING_OFF + F.wave * 16384);
        constexpr int I_IN = (D / 64) * (MIX_IN / 32), I_SQ = (D / 64) * (D / 32), I_KV = (D / 64) * (2 * D / 32), I_W1 = (D / 64) * (2 * FF / 32), I_W2 = (FF / 64) * (D / 32);
        constexpr int NITEMS = I_IN + 2 * I_SQ + I_KV;
        for (int it = F.gw; it < NITEMS; it += F.NGW) {
            int r = it;
            if (r < I_IN) { p0_transpose_item(KIN(3), MIX_IN, D, MIX_IN, KIN(2), WIN_T, scr, r, F.lane, RWKV_IN, RWKV_IN + 512, 0.125f * 1.4426950408889634f); continue; } r -= I_IN;
            if (r < I_SQ) { p0_transpose_item(KIN(20), D, D, D, nullptr, WOUT_T, scr, r, F.lane); continue; } r -= I_SQ;
            if (r < I_SQ) { p0_transpose_item(KIN(25), D, D, D, nullptr, WCO_T, scr, r, F.lane); continue; } r -= I_SQ;
            p0_transpose_item(KIN(24), 2 * D, D, 2 * D, nullptr, WCKV_T, scr, r, F.lane);
        }
        for (int i = F.gt; i < (PROJ_LD - MIX_IN) * D / 8; i += F.NGT) *((v4u*)(WIN_T + (size_t)MIX_IN * D) + i) = (v4u){0u, 0u, 0u, 0u};
        for (int i = F.gt; i < D * D / 4; i += F.NGT) { const int k = i / (D / 4); const f32x4 v = *((const f32x4*)KIN(23) + i); const float g = KIN(21)[k];
            *((v2u*)WCQ_N + i) = (v2u){pk2(v.x * g, v.y * g), pk2(v.z * g, v.w * g)}; }
        for (int i = F.gt; i < C * 288; i += F.NGT) { const int c = i / 288, j = i - c * 288;
            const float v = j < 64 ? KIN(6)[j * C + c] : j < 128 ? KIN(8)[(j - 64) * C + c] : KIN(9)[(j - 128) * C + c]; WL[i] = (bf16)f2bf(v); }
        for (int i = F.gt; i < XROWS; i += F.NGT) TOKOF[i] = 0;
#pragma unroll 2
        for (int m = F.gw; m < T; m += F.NGW) row_to_bf16(F.lane, x + (size_t)m * D, XB + (size_t)m * D, nullptr, false, RSTD0 + m);
        for (int m = F.gw; m < BATCH * MEM; m += F.NGW) row_to_bf16(F.lane, KIN(1) + (size_t)m * D, MN + (size_t)m * D, KIN(22), true, nullptr);
    }
    SEAM(0);
    if (IN(1)) {
        refresh(F); asm volatile("" : "+s"(ws), "+s"(ka));
#if OPT_GEMM
        { pg8::GridSched S{(const char*)XB, (const char*)WIN_T, D, D, T / 256, PROJ_LD / 256, F.G, (int)blockIdx.x, 0, 1 << 30, 0};
          pg8::EpiBf16 E{PROJ, PROJ_LD, RSTD0};
          pg8::gemm_phase<pg8::EpiBf16, pg8::GridSched, true>(F.lds + RING_OFF, F.wave, D, D, D, S, E); }
        { pg8::GridSched S{(const char*)MN, (const char*)WCKV_T, D, D, BATCH * MEM / 256, 2 * D / 256, F.G, (int)blockIdx.x, 128 % F.G, 1 << 30, 0};
          pg8::EpiBf16 E{MKV, 2 * D, nullptr};
          pg8::gemm_phase<pg8::EpiBf16, pg8::GridSched, true>(F.lds + RING_OFF, F.wave, D, D, D, S, E); }
#else
        ref_gemm(F, RefG{XB, D, WIN_T, D, T, PROJ_LD, D}, [&](int row, int col, const float (&a)[4]) { const float s = RSTD0[row];
            *(v2u*)(PROJ + (size_t)row * PROJ_LD + col) = (v2u){pk2(a[0] * s, a[1] * s), pk2(a[2] * s, a[3] * s)}; });
        ref_gemm(F, RefG{MN, D, WCKV_T, D, BATCH * MEM, 2 * D, D}, [&](int row, int col, const float (&a)[4]) {
            *(v2u*)(MKV + (size_t)row * 2 * D + col) = (v2u){pk2(a[0], a[1]), pk2(a[2], a[3])}; });
#endif
    }
    SEAM(1);
    if (IN(2)) {
        refresh(F); asm volatile("" : "+s"(ws), "+s"(ka));
#if OPT_PREP
        {
            typedef float f32x16 __attribute__((ext_vector_type(16)));
            const GAS float* mu = (const GAS float*)KIN(4); const GAS float* w0 = (const GAS float*)KIN(5); const GAS float* a0 = (const GAS float*)KIN(7); const GAS float* k_k = (const GAS float*)KIN(10); const GAS float* k_a = (const GAS float*)KIN(11);
            const long TC = (long)T * C; bf16 *Rr = RS, *Kr = RS + TC, *Vr = RS + 2 * TC, *KKr = RS + 3 * TC, *KKAr = RS + 4 * TC; float* Wr = LWA;
            const rwkv::ChunkBufs cb{(unsigned char*)(ws + WS_GF), (unsigned char*)(ws + WS_HT), (unsigned char*)(ws + WS_RF), (unsigned char*)(ws + WS_Y0)};
            LAS unsigned char* LA = F.lds + RING_OFF; constexpr int LAS_ = 592;
            const int hd = F.wave;
            LAS float* TQ = (LAS float*)(F.lds + RING_OFF + 40960) + F.wave * 1152;
            LAS float* CST = (LAS float*)(F.lds + RING_OFF + 77824);
            for (int i = F.wave * 64 + lane_id(); i < 7 * C; i += NTHR) { const int a = i / C, c = i - a * C;
                CST[i] = a == 0 ? mu[c] : a == 1 ? mu[512 + c] : a == 2 ? mu[1024 + c] : a == 3 ? w0[c] : a == 4 ? a0[c] : a == 5 ? k_k[c] : k_a[c]; }
            for (int tt = F.vcu; tt < T / 64; tt += F.G) { const int t0 = tt * 64;
                {
                    const int ln = lane_id(); float mx = 0.f;
#pragma unroll 2
                    for (int i = 0; i < 8; ++i) { const bf16* pr = PROJ + (size_t)(t0 + F.wave * 8 + i) * PROJ_LD + RWKV_IN + ln * 16; const v4u u0 = *(const v4u*)pr, u1 = *(const v4u*)(pr + 8); float s = 0.f;
#pragma unroll
                        for (int e = 0; e < 4; ++e) { const float a0_ = __uint_as_float(u0[e] << 16), a1_ = __uint_as_float(u0[e] & 0xffff0000u), b0_ = __uint_as_float(u1[e] << 16), b1_ = __uint_as_float(u1[e] & 0xffff0000u); s += a0_ * a0_ + a1_ * a1_ + b0_ * b0_ + b1_ * b1_; }
                        s += __shfl_xor(s, 1); s += __shfl_xor(s, 2); mx = fmaxf(mx, s); }
                    if ((ln & 3) == 0) atomicMax((unsigned*)(F.ctl + CTL_NRM / 4) + (t0 / SEQ) * 16 + (ln >> 2), __float_as_uint(mx)); }
                __syncthreads();
#pragma unroll
                for (int it = 0; it < 5; ++it) { const int idx = it * NTHR + F.wave * 64 + lane_id();
                    if (idx < 64 * 36) { const int t = idx / 36, jg = idx - t * 36, col = 1536 + 8 * jg, row = t0 + t;
                        const v4u y8 = *(const v4u*)(PROJ + (size_t)row * PROJ_LD + col); const v4u p8 = (row % SEQ == 0) ? (v4u){0u, 0u, 0u, 0u} : *(const v4u*)(PROJ + (size_t)(row - 1) * PROJ_LD + col);
                        const f32x4 m0 = *(const GAS f32x4*)(mu + col), m1 = *(const GAS f32x4*)(mu + col + 4); float u[8];
#pragma unroll
                        for (int e = 0; e < 8; ++e) { const float y = __uint_as_float((e & 1) ? (y8[e >> 1] & 0xffff0000u) : (y8[e >> 1] << 16)), yp = __uint_as_float((e & 1) ? (p8[e >> 1] & 0xffff0000u) : (p8[e >> 1] << 16));
                            const float mm = e < 4 ? m0[e & 3] : m1[e & 3]; float v = y + mm * (yp - y);
                            if (jg < 8) v = 1.f - 2.f * __builtin_amdgcn_rcpf(__expf(2.f * v) + 1.f); else if (jg >= 16) v = __builtin_amdgcn_rcpf(1.f + __expf(-v));
                            u[e] = v; }
                        *(LAS v4u*)(LA + t * LAS_ + jg * 16) = (v4u){cvtpk(u[0], u[1]), cvtpk(u[2], u[3]), cvtpk(u[4], u[5]), cvtpk(u[6], u[7])}; } }
                __syncthreads();
#pragma unroll 1
                for (int rt = 0; rt < 2; ++rt) {
                    asm volatile("" : "+s"(mu), "+s"(w0), "+s"(a0), "+s"(k_k), "+s"(k_a));
                    const int r32 = lane_id() & 31, hh = lane_id() >> 5;
                    const int row = t0 + rt * 32 + r32; const bool first = (row % SEQ) == 0; const bf16* p = PROJ + (size_t)row * PROJ_LD; const bf16* pp = first ? p : p - PROJ_LD; const float pm = first ? 0.f : 1.f;
                    float ssq = 0.f;
#pragma unroll
                    for (int ct = 0; ct < 2; ++ct)
#pragma unroll
                        for (int g4 = 0; g4 < 4; ++g4) { const int c = hd * 64 + ct * 32 + 8 * g4 + 4 * hh;
                            const v2u yk = *(const v2u*)(p + 512 + c), pk_ = *(const v2u*)(pp + 512 + c); const f32x4 mk = *(const LAS f32x4*)(CST + 512 + c), kkc = *(const LAS f32x4*)(CST + 5 * 512 + c);
#pragma unroll
                            for (int e = 0; e < 4; ++e) { const float y = __uint_as_float((e & 1) ? (yk[e >> 1] & 0xffff0000u) : (yk[e >> 1] << 16)), yp = pm * __uint_as_float((e & 1) ? (pk_[e >> 1] & 0xffff0000u) : (pk_[e >> 1] << 16));
                                const float kx = y + mk[e] * (yp - y); const float q = kx * kkc[e]; ssq += q * q; } }
                    ssq += __shfl_xor(ssq, 32);
                    const float rn = 1.0f / fmaxf(sqrtf(ssq), 1e-12f);
#pragma unroll
                    for (int ct = 0; ct < 2; ++ct) {
                        f32x16 ad = {}, aa = {}, ag = {};
                        v2u yr[4], pr_[4], yv[4], pv_[4], yk[4], pk_[4];
                        asm volatile("" ::: "memory");
#pragma unroll
                        for (int g4 = 0; g4 < 4; ++g4) { const int c = hd * 64 + ct * 32 + 8 * g4 + 4 * hh;
                            yr[g4] = *(const v2u*)(p + c); pr_[g4] = *(const v2u*)(pp + c); yv[g4] = *(const v2u*)(p + 1024 + c); pv_[g4] = *(const v2u*)(pp + 1024 + c); yk[g4] = *(const v2u*)(p + 512 + c); pk_[g4] = *(const v2u*)(pp + 512 + c); }
                        const GAS bf16* wl0 = (const GAS bf16*)(WL + (size_t)(hd * 64 + ct * 32 + r32) * 288 + 8 * hh); asm volatile("" : "+v"(wl0));
#pragma unroll
                        for (int s = 0; s < 18; ++s) { const bf16x8 fb = *(const LAS bf16x8*)(LA + (rt * 32 + r32) * LAS_ + (16 * s + 8 * hh) * 2); const bf16x8 fa = *(const GAS bf16x8*)(wl0 + 16 * s);
                            if (s < 4) ad = __builtin_amdgcn_mfma_f32_32x32x16_bf16(fa, fb, ad, 0, 0, 0);
                            else if (s < 8) aa = __builtin_amdgcn_mfma_f32_32x32x16_bf16(fa, fb, aa, 0, 0, 0);
                            else ag = __builtin_amdgcn_mfma_f32_32x32x16_bf16(fa, fb, ag, 0, 0, 0); }
                        f32x4 ov[6][4];
#pragma unroll
                        for (int g4 = 0; g4 < 4; ++g4) { const int c = hd * 64 + ct * 32 + 8 * g4 + 4 * hh;
                            const f32x4 mr = *(const LAS f32x4*)(CST + c), mk = *(const LAS f32x4*)(CST + 512 + c), mv = *(const LAS f32x4*)(CST + 1024 + c), w0c = *(const LAS f32x4*)(CST + 3 * 512 + c), a0c = *(const LAS f32x4*)(CST + 4 * 512 + c), kkc = *(const LAS f32x4*)(CST + 5 * 512 + c), kac = *(const LAS f32x4*)(CST + 6 * 512 + c);
#pragma unroll
                            for (int e = 0; e < 4; ++e) { const int r = 4 * g4 + e;
                                const float y1 = __uint_as_float((e & 1) ? (yr[g4][e >> 1] & 0xffff0000u) : (yr[g4][e >> 1] << 16)), p1 = pm * __uint_as_float((e & 1) ? (pr_[g4][e >> 1] & 0xffff0000u) : (pr_[g4][e >> 1] << 16));
                                const float y3 = __uint_as_float((e & 1) ? (yv[g4][e >> 1] & 0xffff0000u) : (yv[g4][e >> 1] << 16)), p3 = pm * __uint_as_float((e & 1) ? (pv_[g4][e >> 1] & 0xffff0000u) : (pv_[g4][e >> 1] << 16));
                                const float y2 = __uint_as_float((e & 1) ? (yk[g4][e >> 1] & 0xffff0000u) : (yk[g4][e >> 1] << 16)), p2 = pm * __uint_as_float((e & 1) ? (pk_[g4][e >> 1] & 0xffff0000u) : (pk_[g4][e >> 1] << 16));
                                const float kx = y2 + mk[e] * (p2 - y2);
                                const float dw = w0c[e] + ad[r]; const float zz = -dw; const float sp = fmaxf(zz, 0.f) + __logf(1.f + __expf(-fabsf(zz)));
                                const float av = __builtin_amdgcn_rcpf(1.f + __expf(-(a0c[e] + aa[r]))); const float kk = kx * kkc[e] * rn;
                                ov[0][g4][e] = y1 + mr[e] * (p1 - y1); ov[1][g4][e] = -__expf(-sp - 0.5f); ov[2][g4][e] = kx * (1.f + (av - 1.f) * kac[e]); ov[3][g4][e] = y3 + mv[e] * (p3 - y3); ov[4][g4][e] = kk; ov[5][g4][e] = kk * av; } }
                        { const int ln = lane_id(); const size_t rb = (size_t)(t0 + rt * 32) * C + hd * 64 + ct * 32;
#pragma unroll
                          for (int a = 0; a < 7; ++a) {
#pragma unroll
                              for (int g4 = 0; g4 < 4; ++g4) *(LAS f32x4*)(TQ + r32 * 36 + 8 * g4 + 4 * hh) = (a < 6) ? ov[a < 6 ? a : 0][g4] : (f32x4){ag[4 * g4], ag[4 * g4 + 1], ag[4 * g4 + 2], ag[4 * g4 + 3]};
                              LDS_WAIT(); asm volatile("" ::: "memory");
                              if (a == 1) {
#pragma unroll
                                  for (int i = 0; i < 4; ++i) { const int tr = (ln >> 3) + 8 * i, cq = (ln & 7) * 4; *(f32x4*)(Wr + rb + (size_t)tr * C + cq) = *(const LAS f32x4*)(TQ + tr * 36 + cq); } }
                              else { bf16* dstp = a == 0 ? Rr : a == 2 ? Kr : a == 3 ? Vr : a == 4 ? KKr : a == 5 ? KKAr : GG;
#pragma unroll
                                  for (int i = 0; i < 2; ++i) { const int tr = (ln >> 2) + 16 * i, cq = (ln & 3) * 8; const f32x4 v0 = *(const LAS f32x4*)(TQ + tr * 36 + cq), v1 = *(const LAS f32x4*)(TQ + tr * 36 + cq + 4);
                                      *(v4u*)(dstp + rb + (size_t)tr * C + cq) = (v4u){cvtpk(v0[0], v0[1]), cvtpk(v0[2], v0[3]), cvtpk(v1[0], v1[1]), cvtpk(v1[2], v1[3])}; } }
                              LDS_WAIT(); asm volatile("" ::: "memory"); } }
                    }
                }
                __syncthreads();
                { const int b = t0 / SEQ, c0 = (t0 % SEQ) / rwkv::L;
#pragma unroll 1
                  for (int rt = 0; rt < 2; ++rt) rwkv::stage1_chunk(F.lds + RING_OFF + F.wave * rwkv::WAVE_LDS, cb, (b * NH + hd) * rwkv::NCH + c0 + rt, Rr, Wr, Kr, Vr, KKr, KKAr, lane_id()); }
            }
        }
#else
        {
            LAS float* su = (LAS float*)(F.lds); LAS float* ssq = su + 2048;
            const float* mu = KIN(4); const float* w0 = KIN(5); const float* Wd = KIN(6); const float* a0 = KIN(7); const float* Wa = KIN(8); const float* Wg = KIN(9);
            const float* k_k = KIN(10); const float* k_a = KIN(11);
            const long TC = (long)T * C; float *Rr = RS, *Wr = RS + TC, *Kr = RS + 2 * TC, *Vr = RS + 3 * TC, *KKr = RS + 4 * TC, *KKAr = RS + 5 * TC;
            const int c = F.tid;
            for (int t = F.vcu; t < T; t += F.G) {
                const bool first = (t % SEQ) == 0; const bf16* p = PROJ + (size_t)t * PROJ_LD; const bf16* pp = p - PROJ_LD;
                __syncthreads();
                for (int j = c; j < RWKV_IN; j += NTHR) { const float y = bf2f(p[j]), yp = first ? 0.f : bf2f(pp[j]); float u = y + mu[j] * (yp - y);
                    if (j >= 1536 && j < 1600) u = tanhf(u); else if (j >= 1664) u = 1.f / (1.f + expf(-u));
                    su[j] = u; }
                __syncthreads();
                float dw = w0[c], da = a0[c], dg = 0.f;
#pragma unroll 4
                for (int i = 0; i < 64; ++i) { dw += su[1536 + i] * Wd[i * C + c]; da += su[1600 + i] * Wa[i * C + c]; }
#pragma unroll 4
                for (int i = 0; i < 160; ++i) dg += su[1664 + i] * Wg[i * C + c];
                const float zz = -dw; const float sp = fmaxf(zz, 0.f) + log1pf(expf(-fabsf(zz)));
                const float decay = -expf(-sp - 0.5f)  ; const float aa = 1.f / (1.f + expf(-da));
                const float r = su[c], k = su[512 + c], v = su[1024 + c];
                const float kkv = k * k_k[c]; ssq[c] = kkv * kkv; __syncthreads();
                float s2 = 0.f; const int h0 = c & ~63;
#pragma unroll 8
                for (int i = 0; i < 64; ++i) s2 += ssq[h0 + i];
                const float kk = kkv / fmaxf(sqrtf(s2), 1e-12f); const float k2 = k * (1.f + (aa - 1.f) * k_a[c]);
                const long o = (long)t * C + c;
                Rr[o] = r; Wr[o] = decay; Kr[o] = k2; Vr[o] = v; KKr[o] = kk; KKAr[o] = kk * aa; GG[o] = dg;
            }
        }
#endif
    }
    SEAM(2);
    if (IN(3)) {
        refresh(F); asm volatile("" : "+s"(ws), "+s"(ka));
#if OPT_GEMM
        { pg8::FoldSched S{(const char*)MKV, (const char*)WCQ_N, 0, F.G, (int)blockIdx.x, 128 % F.G}; pg8::EpiBf16 E{WQK_T, D, nullptr};
          pg8::gemm_phase<pg8::EpiBf16, pg8::FoldSched, true>(F.lds + RING_OFF, F.wave, 256, 2 * D, D, S, E); }
        { pg8::FoldSched S{(const char*)MKV, (const char*)WCO_T, 1, F.G, (int)blockIdx.x, 192 % F.G}; pg8::EpiBf16 E{WVO_T, D, nullptr};
          pg8::gemm_phase<pg8::EpiBf16, pg8::FoldSched, true>(F.lds + RING_OFF, F.wave, 256, D, 2 * D, S, E); }
        __syncthreads();
#else
        for (int z = 0; z < BATCH * 4; ++z) { const int b = z >> 2, h = z & 3;
            ref_gemm(F, RefG{MKV + (size_t)b * MEM * 2 * D + h * 256, 2 * D, WCQ_N + h * 256, D, MEM, D, 256}, [&](int row, int col, const float (&a)[4]) {
                *(v2u*)(WQK_T + ((size_t)b * D + h * 256 + row) * D + col) = (v2u){pk2(a[0], a[1]), pk2(a[2], a[3])}; });
            ref_gemm(F, RefG{WCO_T + h * 256, D, MKV + (size_t)b * MEM * 2 * D + D + h * 256, 2 * D, D, MEM, 256}, [&](int row, int col, const float (&a)[4]) {
                *(v2u*)(WVO_T + ((size_t)b * D + row) * D + h * 256 + col) = (v2u){pk2(a[0], a[1]), pk2(a[2], a[3])}; });
        }
#endif
#if OPT_ATTN
        {
            const int ng = (F.G % 8 == 0) ? 8 : 1, gsz = F.G / ng, xg = F.vcu / gsz, wl = F.vcu - xg * gsz;
            const int nsl = 32 / ng;
            if (wl < nsl) { const int sid = (xg * nsl + wl) * 2 + F.wave;
                if (F.wave < 2) { const rwkv::ChunkBufs cb{(unsigned char*)(ws + WS_GF), (unsigned char*)(ws + WS_HT), (unsigned char*)(ws + WS_RF), (unsigned char*)(ws + WS_Y0)};
                    rwkv::stage2(cb, sid >> 1, sid & 1, (float*)(ws + WS_YRAW), lane_id()); }
                __syncthreads(); }
            else if (wl < nsl + (CONV_EIGHTHS * gsz) / 8) {
                constexpr int I_W1 = (D / 64) * (2 * FF / 32), I_W2 = (FF / 64) * (D / 32), NMOE = NE * (I_W1 + I_W2);
                LAS float* scr = (LAS float*)(F.lds + RING_OFF + F.wave * 16384); gu32* CQ = F.ctl + CTL_Q / 4 + 8 * 64;
                for (;;) {
                    if (F.wave == 0 && lane_id() == 0) F.MISC[16] = __hip_atomic_fetch_add(CQ, 64u, RLX_AGENT);
                    __syncthreads(); const int base = (int)F.MISC[16]; __syncthreads();
                    if (base >= NMOE) break;
#pragma unroll 1
                    for (int i = 0; i < 8; i += 2) {
                        TItem ti[2]; bool ok[2];
#pragma unroll
                        for (int u = 0; u < 2; ++u) { int r = base + F.wave * 8 + i + u; ok[u] = r < NMOE; if (!ok[u]) r = NMOE - 1;
                            const int e = r / (I_W1 + I_W2); r -= e * (I_W1 + I_W2); const bool w1 = r < I_W1; const int it = w1 ? r : r - I_W1; const int N = w1 ? 2 * FF : D, nblk = N / 32;
                            ti[u].W = (const GAS float*)(w1 ? KIN(29) + (size_t)e * D * 2 * FF : KIN(31) + (size_t)e * FF * D); ti[u].WT = (GAS bf16*)(w1 ? W1_T + (size_t)e * 2 * FF * D : W2_T + (size_t)e * D * FF);
                            ti[u].rowg = (const GAS float*)(w1 ? KIN(26) : nullptr); ti[u].ldw = N; ti[u].K = D; ti[u].k0 = 64 * (it / nblk); ti[u].n0 = 32 * (it % nblk); }
                        f32x4 va[8], vb[8]; float ga[8], gb[8]; const int ln = lane_id();
                        p0_t_load(ti[0], va, ga, ln); p0_t_load(ti[1], vb, gb, ln);
                        if (ok[0]) p0_t_finish(ti[0], va, ga, scr, ln);
                        if (ok[1]) p0_t_finish(ti[1], vb, gb, scr, ln); }
                }
                __syncthreads(); }
            const int upq = 1024 / ng;
            for (int gi = 0; gi < ng; ++gi) { const int qg = (xg + gi) % ng; gu32* Q = F.ctl + CTL_Q / 4 + qg * 64;
            for (;;) {
                if (F.wave == 0 && lane_id() == 0) F.MISC[16] = __hip_atomic_fetch_add(Q, 1u, RLX_AGENT);
                __syncthreads(); const int idx = (int)F.MISC[16]; __syncthreads();
                if (idx >= upq) break;
                const int qb = 15 - idx / (upq / 16), hc = qg * (64 / ng) + idx % (upq / 16);
                const int b = hc >> 4, h = (hc >> 2) & 3, cm = (hc >> 1) & 1, vh = hc & 1;
                const bf16* pb = PROJ + (size_t)b * SEQ * PROJ_LD + RWKV_IN + h * 128;
                int tstart = 0;
                {
                    const unsigned* nr = (const unsigned*)(F.ctl + CTL_NRM / 4) + b * 16; const float q2 = __uint_as_float(__hip_atomic_load(nr + h * 2 + cm, RLX_AGENT)), k2 = __uint_as_float(__hip_atomic_load(nr + 8 + h * 2 + cm, RLX_AGENT));
                    const float xmax = sqrtf(q2 * k2) * 1.01f + 2.f, beta_ = exp2f(-2.0f * (h + 1)) * 1.4426950408889634f;
                    const float lim = (float)(qb * 256 - 63) - (xmax + 152.f) / beta_;
                    if (ATTN_SKIP && lim > 0.f) { tstart = ((int)(lim * (1.f / 64.f))) & ~1; const int ntall = 4 * qb + 4; if (tstart > ntall - 4) tstart = ntall - 4; if (tstart < 0) tstart = 0; } }
                attn_body::attn_unit<8>(F.wave, qb, tstart, pb + cm * 64, pb + 512 + cm * 64, pb + 1024 + vh * 64, OC + ((size_t)cm * T + (size_t)b * SEQ) * C + h * 128 + vh * 64, exp2f(-2.0f * (h + 1)) * 1.4426950408889634f, (char*)lds + RING_OFF);
            } }
        }
#else
        for (int u = F.vcu; u < BATCH * 8 * (SEQ / NTHR); u += F.G) {
            const int qb = u % (SEQ / NTHR), hc = (u / (SEQ / NTHR)) % 8, b = u / (8 * (SEQ / NTHR)); const int h = hc >> 1, cm = hc & 1;
            const int q = qb * NTHR + F.tid; const float slope = exp2f(-2.0f * (h + 1)) * 1.4426950408889634f;
            const bf16* base = PROJ + (size_t)b * SEQ * PROJ_LD + RWKV_IN; const bf16* qp = base + (size_t)q * PROJ_LD + h * 128 + cm * 64;
            float qr[64];
#pragma unroll
            for (int d = 0; d < 64; ++d) qr[d] = bf2f(qp[d]);
            float o[128];
#pragma unroll
            for (int e = 0; e < 128; ++e) o[e] = 0.f;
            float m = -INFINITY, l = 0.f; const int jmax = qb * NTHR + NTHR - 1;
            for (int j = 0; j <= jmax; ++j) {
                const bf16* kp = base + (size_t)j * PROJ_LD + 512 + h * 128 + cm * 64; const bf16* vp = base + (size_t)j * PROJ_LD + 1024 + h * 128;
                if (j <= q) {
                    float sc = 0.f;
#pragma unroll
                    for (int d = 0; d < 64; ++d) sc += qr[d] * bf2f(kp[d]);
                    sc -= slope * (float)(q - j);
                    if (sc > m) { const float f = exp2f(m - sc); l *= f;
#pragma unroll
                        for (int e = 0; e < 128; ++e) o[e] *= f;
                        m = sc; }
                    const float pr = exp2f(sc - m); l += pr;
#pragma unroll
                    for (int e = 0; e < 128; ++e) o[e] += pr * bf2f(vp[e]);
                }
            }
            const float il = 1.f / l; bf16* op = OC + ((size_t)cm * T + (size_t)b * SEQ + q) * C + h * 128;
#pragma unroll
            for (int e = 0; e < 128; ++e) op[e] = (bf16)f2bf(o[e] * il);
        }
#endif
    }
    SEAM(3);
    if (IN(5)) {
        refresh(F); asm volatile("" : "+s"(ws), "+s"(ka));
        const float s1 = wave_sum(KIN(15)[F.lane] * KIN(16)[F.lane]), s2 = wave_sum(KIN(17)[F.lane] * KIN(18)[F.lane]);
        const float lam = expf(s1) - expf(s2) + 0.2f; const float* sg = KIN(19);
        {
            const long TC = (long)T * C; const bf16 *Rr = RS, *Kr = RS + TC, *Vr = RS + 2 * TC; const float* YRAW = (const float*)(ws + WS_YRAW);
            const int c0 = F.lane * 8;
            f32x4 lg[2], lb[2], rk[2], sgv[2];
#pragma unroll
            for (int q = 0; q < 2; ++q) { lg[q] = *(const f32x4*)(KIN(13) + c0 + 4 * q); lb[q] = *(const f32x4*)(KIN(14) + c0 + 4 * q); rk[q] = *(const f32x4*)(KIN(12) + c0 + 4 * q); sgv[q] = *(const f32x4*)(sg + (c0 & 127) + 4 * q); }
#pragma unroll 2
            for (int t = F.gw; t < T; t += F.NGW) { const size_t o = (size_t)t * C + c0;
                f32x4 y[2], r[2], kx[2], vv[2], g[2];
#pragma unroll
                for (int q = 0; q < 2; ++q) y[q] = *(const f32x4*)(YRAW + o + 4 * q);
                { const v4u ur = *(const v4u*)(Rr + o), uk = *(const v4u*)(Kr + o), uv = *(const v4u*)(Vr + o), ug = *(const v4u*)(GG + o);
#pragma unroll
                  for (int e = 0; e < 4; ++e) { r[e >> 1][2 * (e & 1)] = __uint_as_float(ur[e] << 16); r[e >> 1][2 * (e & 1) + 1] = __uint_as_float(ur[e] & 0xffff0000u); kx[e >> 1][2 * (e & 1)] = __uint_as_float(uk[e] << 16); kx[e >> 1][2 * (e & 1) + 1] = __uint_as_float(uk[e] & 0xffff0000u);
                      vv[e >> 1][2 * (e & 1)] = __uint_as_float(uv[e] << 16); vv[e >> 1][2 * (e & 1) + 1] = __uint_as_float(uv[e] & 0xffff0000u); g[e >> 1][2 * (e & 1)] = __uint_as_float(ug[e] << 16); g[e >> 1][2 * (e & 1) + 1] = __uint_as_float(ug[e] & 0xffff0000u); } }
                const v4u a0 = *(const v4u*)(OC + (size_t)t * C + c0), a1 = *(const v4u*)(OC + ((size_t)T + t) * C + c0);
                float s = 0.f, bsum = 0.f;
#pragma unroll
                for (int q = 0; q < 2; ++q) { s += (y[q].x + y[q].y) + (y[q].z + y[q].w); const f32x4 pr = r[q] * kx[q] * rk[q]; bsum += (pr.x + pr.y) + (pr.z + pr.w); }
                s += __shfl_xor(s, 1); s += __shfl_xor(s, 2); s += __shfl_xor(s, 4); bsum += __shfl_xor(bsum, 1); bsum += __shfl_xor(bsum, 2); bsum += __shfl_xor(bsum, 4);
                const float mu_ = s * (1.f / 64.f); float var = 0.f;
#pragma unroll
                for (int q = 0; q < 2; ++q) { const f32x4 d = y[q] - mu_; var += (d.x * d.x + d.y * d.y) + (d.z * d.z + d.w * d.w); }
                var += __shfl_xor(var, 1); var += __shfl_xor(var, 2); var += __shfl_xor(var, 4);
                const float rstd = 1.0f / sqrtf(var * (1.f / 64.f) + GN_EPS);
                v4u w;
#pragma unroll
                for (int q = 0; q < 2; ++q) { const f32x4 o4 = (((y[q] - mu_) * rstd) * lg[q] + lb[q] + vv[q] * bsum) * g[q]; w[2 * q] = pk2(o4.x, o4.y); w[2 * q + 1] = pk2(o4.z, o4.w); }
                *(v4u*)(Y + (size_t)t * D + c0) = w;
                float d8[8]; float ssd = 0.f;
#pragma unroll
                for (int e = 0; e < 4; ++e) { d8[2 * e] = __uint_as_float(a0[e] << 16) - lam * __uint_as_float(a1[e] << 16); d8[2 * e + 1] = __uint_as_float(a0[e] & 0xffff0000u) - lam * __uint_as_float(a1[e] & 0xffff0000u); ssd += d8[2 * e] * d8[2 * e] + d8[2 * e + 1] * d8[2 * e + 1]; }
                ssd += __shfl_xor(ssd, 1); ssd += __shfl_xor(ssd, 2); ssd += __shfl_xor(ssd, 4); ssd += __shfl_xor(ssd, 8);
                const float rsd = 0.8f / sqrtf(ssd * (1.f / 128.f) + NORM_EPS);
                v4u wd; wd.x = pk2(d8[0] * rsd * sgv[0].x, d8[1] * rsd * sgv[0].y); wd.y = pk2(d8[2] * rsd * sgv[0].z, d8[3] * rsd * sgv[0].w); wd.z = pk2(d8[4] * rsd * sgv[1].x, d8[5] * rsd * sgv[1].y); wd.w = pk2(d8[6] * rsd * sgv[1].z, d8[7] * rsd * sgv[1].w);
                *(v4u*)(Y + (size_t)t * D + C + c0) = wd;
            }
        }
    }
    SEAM(5);
    if (IN(6)) {
        refresh(F); asm volatile("" : "+s"(ws), "+s"(ka));
#if OPT_GEMM
        pg8::GridSched S{(const char*)Y, (const char*)WOUT_T, D, D, T / 256, D / 256, F.G, (int)blockIdx.x, 0, 1 << 30, 0};
        pg8::EpiResid E{x, nullptr, nullptr, X1B, SS1};
        pg8::gemm_phase<pg8::EpiResid, pg8::GridSched, true>(F.lds + RING_OFF, F.wave, D, D, D, S, E);
#else
        ref_gemm(F, RefG{Y, D, WOUT_T, D, T, D, D}, [&](int row, int col, const float (&a)[4]) { float q = 0.f;
            for (int j = 0; j < 4; ++j) { const float v = x[(size_t)row * D + col + j] + a[j]; X1[(size_t)row * D + col + j] = v; X1B[(size_t)row * D + col + j] = (bf16)f2bf(v); q += v * v; }
            atomicAdd(SS1 + row, q); });
#endif
    }
    SEAM(6);
    if (IN(7)) {
        refresh(F); asm volatile("" : "+s"(ws), "+s"(ka));
#if OPT_GEMM
        pg8::GridSched S{(const char*)X1B, (const char*)WQK_T, D, D, T / 256, D / 256, F.G, (int)blockIdx.x, 0, SEQ, (size_t)D * D * 2};
        pg8::EpiSoftmax E{P, SS1, 1.4426950408889634f / 16.f, (LAS float*)(F.lds + EPIX_OFF)};
        pg8::gemm_phase<pg8::EpiSoftmax, pg8::GridSched, true>(F.lds + RING_OFF, F.wave, D, D, D, S, E);
#else
        for (int b = 0; b < BATCH; ++b)
            ref_gemm(F, RefG{X1B + (size_t)b * SEQ * D, D, WQK_T + (size_t)b * D * D, D, SEQ, D, D}, [&](int row, int col, const float (&a)[4]) { const int grow = b * SEQ + row;
                const float s = (1.0f / sqrtf(SS1[grow] * (1.f / D) + NORM_EPS)) * (1.4426950408889634f / 16.f);
                for (int j = 0; j < 4; ++j) TMP[(size_t)grow * D + col + j] = a[j] * s; });
#endif
    }
    SEAM(7);
    if (IN(8) && !OPT_GEMM) {
        refresh(F); asm volatile("" : "+s"(ws), "+s"(ka));
        for (int seg = F.gw; seg < T * 4; seg += F.NGW) { const float* p = TMP + (size_t)seg * 256; float v[4]; float m = -INFINITY;
            for (int i = 0; i < 4; ++i) { v[i] = p[F.lane + 64 * i]; m = fmaxf(m, v[i]); }
            for (int q = 1; q < 64; q <<= 1) m = fmaxf(m, __shfl_xor(m, q));
            float l = 0.f; for (int i = 0; i < 4; ++i) { v[i] = exp2f(v[i] - m); l += v[i]; }
            l = wave_sum(l); const float il = 1.f / l;
            for (int i = 0; i < 4; ++i) P[(size_t)seg * 256 + F.lane + 64 * i] = (bf16)f2bf(v[i] * il); }
    }
#if !OPT_GEMM
    SEAM(8);
#endif
    if (IN(9)) {
        refresh(F); asm volatile("" : "+s"(ws), "+s"(ka));
#if OPT_GEMM
        pg8::GridSched S{(const char*)P, (const char*)WVO_T, D, D, T / 256, D / 256, F.G, (int)blockIdx.x, 0, SEQ, (size_t)D * D * 2};
        pg8::EpiResid E{nullptr, X1B, X2, X2B, SS2};
        pg8::gemm_phase<pg8::EpiResid, pg8::GridSched, true>(F.lds + RING_OFF, F.wave, D, D, D, S, E);
#else
        for (int b = 0; b < BATCH; ++b)
            ref_gemm(F, RefG{P + (size_t)b * SEQ * D, D, WVO_T + (size_t)b * D * D, D, SEQ, D, D}, [&](int row, int col, const float (&a)[4]) { const int grow = b * SEQ + row; float q = 0.f;
                for (int j = 0; j < 4; ++j) { const float v = X1[(size_t)grow * D + col + j] + a[j]; X2[(size_t)grow * D + col + j] = v; X2B[(size_t)grow * D + col + j] = (bf16)f2bf(v); q += v * v; }
                atomicAdd(SS2 + grow, q); });
#endif
    }
    SEAM(9);
    if (IN(10)) {
        refresh(F); asm volatile("" : "+s"(ws), "+s"(ka));
#if OPT_ROUTER
        {
            typedef float f32x16 __attribute__((ext_vector_type(16)));
            const float* wr = KIN(27); const float* br = KIN(28); const float* gf = KIN(26);
            const int tp = F.wave >> 2, q = F.wave & 3, e = F.lane & 31, kh = F.lane >> 5;
            float wreg[128];
#pragma unroll
            for (int i = 0; i < 128; ++i) { const int kk = 256 * q + 8 * (i >> 2) + 4 * kh + (i & 3); wreg[i] = wr[kk * NE + e] * gf[kk]; }
            LAS float* PT = (LAS float*)(F.lds + RING_OFF); LAS float* LT = (LAS float*)(F.lds + RING_OFF + 32768); LAS int* WC = (LAS int*)(F.lds + RING_OFF + 49152);
            for (int pair = F.vcu; pair < T / 64; pair += F.G) {
                const int t0 = pair * 64 + tp * 32;
                const float* xrow = X2 + (size_t)(t0 + e) * D + 256 * q + 4 * kh;
                f32x16 acc = {};
#pragma unroll
                for (int blk = 0; blk < 32; ++blk) { if ((blk & 7) == 0) asm volatile("" ::: "memory");
                    const f32x4 xa = *(const f32x4*)(xrow + 8 * blk);
#pragma unroll
                    for (int j = 0; j < 4; ++j) acc = __builtin_amdgcn_mfma_f32_32x32x2f32(xa[j], wreg[4 * blk + j], acc, 0, 0, 0); }
                __syncthreads();
                if (F.tid < NE) WC[F.tid] = 0;
#pragma unroll
                for (int r = 0; r < 16; ++r) PT[((tp * 4 + q) * 64 + F.lane) * 16 + r] = acc[r];
                __syncthreads();
                if (q == 0) {
#pragma unroll
                    for (int r = 0; r < 16; ++r) { float sacc = 0.f;
#pragma unroll
                        for (int qq = 0; qq < 4; ++qq) sacc += PT[((tp * 4 + qq) * 64 + F.lane) * 16 + r];
                        LT[(tp * 32 + ((r & 3) + 8 * (r >> 2) + 4 * kh)) * 33 + e] = sacc; }
                    asm volatile("s_waitcnt lgkmcnt(0)" ::: "memory");
                    if (F.lane < 32) { const int t = t0 + F.lane; float lg[NE];
                        const float rs = 1.0f / sqrtf(SS2[t] * (1.f / D) + NORM_EPS);
#pragma unroll
                        for (int ee = 0; ee < NE; ++ee) lg[ee] = LT[(tp * 32 + F.lane) * 33 + ee] * rs + br[ee];
                        int sel[4]; float val[4];
#pragma unroll
                        for (int s = 0; s < 4; ++s) { float best = -INFINITY; int bi = 0;
#pragma unroll
                            for (int ee = 0; ee < NE; ++ee) { const bool ok = lg[ee] > best; best = ok ? lg[ee] : best; bi = ok ? ee : bi; }
                            sel[s] = bi; val[s] = best;
#pragma unroll
                            for (int ee = 0; ee < NE; ++ee) if (ee == bi) lg[ee] = -INFINITY; }
                        float sum = 0.f, pe[4];
#pragma unroll
                        for (int s = 0; s < 4; ++s) { pe[s] = expf(val[s] - val[0]); sum += pe[s]; }
#pragma unroll
                        for (int s = 0; s < 4; ++s) { const int slot = t * 4 + s; GATE[slot] = pe[s] / sum;
                            const int rank = __hip_atomic_fetch_add(WC + sel[s], 1, __ATOMIC_RELAXED, __HIP_MEMORY_SCOPE_WORKGROUP);
                            SELR[slot] = sel[s] | (rank << 8); }
                    }
                }
                __syncthreads();
                if (F.tid < NE) WCNT[pair * NE + F.tid] = WC[F.tid];
            }
        }
#else
        const float* wr = KIN(27); const float* br = KIN(28); const float* gf = KIN(26);
        for (int t = F.gt; t < T; t += F.NGT) {
            float lg[NE];
#pragma unroll
            for (int e = 0; e < NE; ++e) lg[e] = 0.f;
            const float* hr = X2 + (size_t)t * D;
            for (int k = 0; k < D; ++k) { const float hv = hr[k] * gf[k];
#pragma unroll
                for (int e = 0; e < NE; ++e) lg[e] += hv * wr[k * NE + e]; }
            const float rs = 1.0f / sqrtf(SS2[t] * (1.f / D) + NORM_EPS);
#pragma unroll
            for (int e = 0; e < NE; ++e) lg[e] = lg[e] * rs + br[e];
            int sel[4]; float val[4];
#pragma unroll
            for (int s = 0; s < 4; ++s) { float best = -INFINITY; int bi = 0;
#pragma unroll
                for (int e = 0; e < NE; ++e) { const bool ok = lg[e] > best; best = ok ? lg[e] : best; bi = ok ? e : bi; }
                sel[s] = bi; val[s] = best;
#pragma unroll
                for (int e = 0; e < NE; ++e) if (e == bi) lg[e] = -INFINITY; }
            float sum = 0.f, pe[4];
#pragma unroll
            for (int s = 0; s < 4; ++s) { pe[s] = expf(val[s] - val[0]); sum += pe[s]; }
#pragma unroll
            for (int s = 0; s < 4; ++s) { const int slot = t * 4 + s; GATE[slot] = pe[s] / sum; const int pos = atomicAdd(&CNT[sel[s]], 1); LIST[(size_t)sel[s] * T + pos] = slot; }
        }
#endif
    }
    SEAM(10);
    if (IN(11)) {
        refresh(F); asm volatile("" : "+s"(ws), "+s"(ka));
#if OPT_ROUTER
        {
            LAS int* SB = (LAS int*)(F.lds + RING_OFF);
            for (int pair = F.vcu; pair < T / 64; pair += F.G) {
                __syncthreads();
                { const int e = F.lane & 31, p0 = (F.wave * 2 + (F.lane >> 5)) * 16; int sa = 0, sb = 0;
#pragma unroll 4
                  for (int p = p0; p < p0 + 16; ++p) { const int v = WCNT[p * NE + e]; sa += v; sb += (p < pair) ? v : 0; }
                  sa += __shfl_xor(sa, 32); sb += __shfl_xor(sb, 32);
                  if (F.lane < 32) { SB[F.wave * 32 + e] = sa; SB[256 + F.wave * 32 + e] = sb; } }
                __syncthreads();
                if (F.wave == 0) { const int e = F.lane & 31; int tot = 0, wo = 0;
#pragma unroll
                    for (int w = 0; w < 8; ++w) { tot += SB[w * 32 + e]; wo += SB[256 + w * 32 + e]; }
                    const int pad = (tot + 255) & ~255; int incl = pad;
#pragma unroll
                    for (int o = 1; o < 32; o <<= 1) { const int v = __shfl_up(incl, o, 32); if (e >= o) incl += v; }
                    if (F.lane < 32) { SB[512 + e] = incl - pad + wo; if (pair == 0) CNT[e] = tot; } }
                __syncthreads();
                if (F.lane < 32) { const int slot = pair * 256 + F.wave * 32 + F.lane, tok = slot >> 2; const int sr = SELR[slot]; const int row = SB[512 + (sr & 255)] + (sr >> 8);
                    TOKOF[row] = tok; ROWOF[slot] = row; RS2[row] = 1.0f / sqrtf(SS2[tok] * (1.f / D) + NORM_EPS); RG[row] = GATE[slot]; }
            }
        }
#else
        for (int e = 0; e < NE; ++e) { const int base = __shfl(ebase_l, e), cnt = __shfl(ecnt_l, e);
            for (int i = F.gw; i < cnt; i += F.NGW) { const int slot = LIST[(size_t)e * T + i], tok = slot >> 2, row = base + i;
                const v4u* src = (const v4u*)(X2B + (size_t)tok * D); v4u* dst = (v4u*)(XG + (size_t)row * D);
                dst[F.lane] = src[F.lane]; dst[F.lane + 64] = src[F.lane + 64];
                if (F.lane == 0) { ROWOF[slot] = row; RS2[row] = 1.0f / sqrtf(SS2[tok] * (1.f / D) + NORM_EPS); RG[row] = GATE[slot]; } } }
#endif
    }
    SEAM(11);
    if (IN(12) || IN(13)) {
        refresh(F); asm volatile("" : "+s"(ws), "+s"(ka));
        const int e = F.lane & 31; const int ecnt = __hip_atomic_load((const int*)CNT + e, RLX_AGENT); const int pad = (ecnt + 255) & ~255; int incl = pad;
#pragma unroll
        for (int o = 1; o < 32; o <<= 1) { const int v = __shfl_up(incl, o, 32); if (e >= o) incl += v; }
        if (F.wave == 0 && F.lane < 32) { F.MISC[32 + e] = (unsigned)(incl - pad); F.MISC[64 + e] = (unsigned)ecnt; if (e == 31) F.MISC[96] = (unsigned)(incl / 256); }
        __syncthreads();
    }
    if (IN(12)) {
        refresh(F); asm volatile("" : "+s"(ws), "+s"(ka));
#if OPT_GEMM
        pg8::MoeSched S{(const char*)X2B, (const char*)W1_T, TOKOF, D, D, 2 * FF / 256, F.G, (int)blockIdx.x, F.MISC + 32, (size_t)2 * FF * D * 2};
        pg8::EpiMoe1 E{ACT, RS2, KIN(30)};
        pg8::gemm_phase<pg8::EpiMoe1, pg8::MoeSched, true, true>(F.lds + RING_OFF, F.wave, D, D, D, S, E);
#else
        for (int e = 0; e < NE; ++e) { const int base = __shfl(ebase_l, e), cnt = __shfl(ecnt_l, e);
            ref_gemm(F, RefG{XG + (size_t)base * D, D, W1_T + (size_t)e * 2 * FF * D, D, cnt, 2 * FF, D}, [&](int row, int col, const float (&a)[4]) { const int grow = base + row; const float s = RS2[grow];
                const float* bb = KIN(30) + (size_t)e * 2 * FF + col;
                ACT[(size_t)grow * FF + (col >> 1)] = (bf16)f2bf(swiglu_f(a[0] * s + bb[0], a[1] * s + bb[1])); ACT[(size_t)grow * FF + (col >> 1) + 1] = (bf16)f2bf(swiglu_f(a[2] * s + bb[2], a[3] * s + bb[3])); }); }
#endif
    }
    SEAM(12);
    if (IN(13)) {
        refresh(F); asm volatile("" : "+s"(ws), "+s"(ka));
#if OPT_GEMM
        pg8::MoeSched S{(const char*)ACT, (const char*)W2_T, nullptr, FF, FF, D / 256, F.G, (int)blockIdx.x, F.MISC + 32, (size_t)D * FF * 2};
        pg8::EpiMoe2 E{YE, RG, KIN(32)};
        pg8::gemm_phase<pg8::EpiMoe2, pg8::MoeSched, true>(F.lds + RING_OFF, F.wave, FF, FF, FF, S, E);
#else
        for (int e = 0; e < NE; ++e) { const int base = __shfl(ebase_l, e), cnt = __shfl(ecnt_l, e);
            ref_gemm(F, RefG{ACT + (size_t)base * FF, FF, W2_T + (size_t)e * D * FF, FF, cnt, D, FF}, [&](int row, int col, const float (&a)[4]) { const int grow = base + row; const float s = RG[grow];
                const float* bb = KIN(32) + (size_t)e * D + col;
                *(v2u*)(YE + (size_t)grow * D + col) = (v2u){pk2((a[0] + bb[0]) * s, (a[1] + bb[1]) * s), pk2((a[2] + bb[2]) * s, (a[3] + bb[3]) * s)}; }); }
#endif
    }
    SEAM(13);
    if (IN(14)) {
        refresh(F); asm volatile("" : "+s"(ws), "+s"(ka));
        const float* gfin = KIN(33);
        for (int t = F.gw; t < T; t += F.NGW) {
            int ro[4];
#pragma unroll
            for (int kq = 0; kq < 4; ++kq) ro[kq] = ROWOF[t * 4 + kq];
            const int c0 = F.lane * 16; f32x4 v[4];
#pragma unroll
            for (int q = 0; q < 4; ++q) v[q] = *(const f32x4*)(X2 + (size_t)t * D + c0 + 4 * q);
#pragma unroll
            for (int kq = 0; kq < 4; ++kq) { const v4u a = *(const v4u*)(YE + (size_t)ro[kq] * D + c0), b = *(const v4u*)(YE + (size_t)ro[kq] * D + c0 + 8);
#pragma unroll
                for (int e = 0; e < 4; ++e) { v[e >> 1][2 * (e & 1)] += __uint_as_float(a[e] << 16); v[e >> 1][2 * (e & 1) + 1] += __uint_as_float(a[e] & 0xffff0000u);
                                              v[2 + (e >> 1)][2 * (e & 1)] += __uint_as_float(b[e] << 16); v[2 + (e >> 1)][2 * (e & 1) + 1] += __uint_as_float(b[e] & 0xffff0000u); } }
            float ss = 0.f;
#pragma unroll
            for (int q = 0; q < 4; ++q) ss += (v[q].x * v[q].x + v[q].y * v[q].y) + (v[q].z * v[q].z + v[q].w * v[q].w);
            const float rs = 1.0f / sqrtf(wave_sum(ss) * (1.f / D) + NORM_EPS);
#pragma unroll
            for (int q = 0; q < 4; ++q) { const f32x4 g = *(const f32x4*)(gfin + c0 + 4 * q); *(f32x4*)(KOUT + (size_t)t * D + c0 + 4 * q) = v[q] * rs * g; }
        }
    }
#undef XB
#undef RSTD0
#undef WIN_T
#undef WOUT_T
#undef WCQ_N
#undef WCKV_T
#undef WCO_T
#undef MN
#undef MKV
#undef WQK_T
#undef WVO_T
#undef WL
#undef W1_T
#undef W2_T
#undef PROJ
#undef Y
#undef X1
#undef X1B
#undef P
#undef X2
#undef X2B
#undef SS1
#undef SS2
#undef CNT
#undef GATE
#undef ROWOF
#undef TOKOF
#undef LIST
#undef WCNT
#undef SELR
#undef RS2
#undef RG
#undef XG
#undef ACT
#undef YE
#undef RS
#undef GG
#undef LWA
#undef OC
#undef TMP
#undef KIN
#undef KOUT
#undef IN
#undef SEAM
}

constexpr int N_PHASES = 15;
#ifndef MK_N_LAUNCHES
#define MK_N_LAUNCHES 1
#endif
extern "C" void kernel_launch(void* const* d_in, const int* in_sizes, int n_in, void* d_out, int out_size, void* d_ws, size_t ws_size, hipStream_t stream) {
    static int grid = 0;
    if (grid == 0) {
        int dev = 0, cus = 0, per_cu = 0;
        if (n_in != 34 || out_size != T * D || ws_size < WS_END) { fprintf(stderr, "kernel_launch: unexpected problem shape (n_in %d out %d ws %zu)\n", n_in, out_size, ws_size); grid = -1; return; }
        if (hipGetDevice(&dev) != hipSuccess || hipDeviceGetAttribute(&cus, hipDeviceAttributeMultiprocessorCount, dev) != hipSuccess) { grid = -1; return; }
        if (hipFuncSetAttribute((const void*)mk_fwd, hipFuncAttributeMaxDynamicSharedMemorySize, LDS_BYTES) != hipSuccess) { fprintf(stderr, "kernel_launch: hipFuncSetAttribute failed\n"); grid = -1; return; }
        if (hipOccupancyMaxActiveBlocksPerMultiprocessor(&per_cu, (const void*)mk_fwd, NTHR, LDS_BYTES) != hipSuccess || per_cu < 1) { fprintf(stderr, "kernel_launch: occupancy query says %d\n", per_cu); per_cu = 1; }
        (void)hipGetLastError();
        grid = cus;
    }
    if (grid < 0) return;
    (void)hipMemsetAsync((char*)d_ws + WS_CTL, 0, CTL_ZERO_BYTES, stream);
    Args a{};
    for (int i = 0; i < 34; ++i) a.in[i] = (const float*)d_in[i];
    a.out = (float*)d_out; a.ws = (unsigned char*)d_ws;
#ifndef MK_LAST_PHASE
#define MK_LAST_PHASE N_PHASES
#endif
    if (MK_REPEAT_PHASE >= 0) {
        a.ph_lo = 0; a.ph_hi = MK_REPEAT_PHASE + 1; a.li = 0; hipLaunchKernelGGL(mk_fwd, dim3(grid), dim3(NTHR), LDS_BYTES, stream, a);
        a.ph_lo = MK_REPEAT_PHASE; a.ph_hi = N_PHASES; a.li = 1; hipLaunchKernelGGL(mk_fwd, dim3(grid), dim3(NTHR), LDS_BYTES, stream, a); }
    else if (MK_N_LAUNCHES == 1) { a.ph_lo = 0; a.ph_hi = MK_LAST_PHASE; hipLaunchKernelGGL(mk_fwd, dim3(grid), dim3(NTHR), LDS_BYTES, stream, a); }
    else for (int p = 0; p < N_PHASES; ++p) { a.ph_lo = p; a.ph_hi = p + 1; a.li = p; hipLaunchKernelGGL(mk_fwd, dim3(grid), dim3(NTHR), LDS_BYTES, stream, a); }
}
```

```cpp
#include <hip/hip_runtime.h>
#include <math.h>
#include <stdint.h>
#include <cstdio>

constexpr int D = 1024, BATCH = 4, SEQ = 4096, T = BATCH * SEQ, MEM = 256;
constexpr int C = 512, NH = 8, HN = 64, RWKV_IN = 1824, MIX_IN = 3360, PROJ_LD = 3584;
constexpr int NE = 32, FF = 1024;
constexpr float NORM_EPS = 1e-5f, GN_EPS = 64e-5f;
constexpr int NWAVES = 8, NTHR = 512;
constexpr int XROWS = T * 4 + NE * 256;

#ifndef REFRESH_OPAQUE
#define REFRESH_OPAQUE 1
#endif
#define GAS __attribute__((address_space(1)))
#define LAS __attribute__((address_space(3)))
typedef unsigned short bf16;
typedef unsigned v4u __attribute__((ext_vector_type(4)));
typedef unsigned v2u __attribute__((ext_vector_type(2)));
typedef float f32x4 __attribute__((ext_vector_type(4)));
typedef short bf16x8 __attribute__((ext_vector_type(8)));
typedef GAS unsigned gu32;
#define RLX_AGENT __ATOMIC_RELAXED, __HIP_MEMORY_SCOPE_AGENT
#define LDS_WAIT() asm volatile("s_waitcnt lgkmcnt(0)" ::: "memory")
#define VM_WAIT() asm volatile("s_waitcnt vmcnt(0)" ::: "memory")
__device__ __forceinline__ unsigned f2bf(float f) { unsigned u = __builtin_bit_cast(unsigned, f); return (u + 0x7fffu + ((u >> 16) & 1u)) >> 16; }
__device__ __forceinline__ unsigned pk2(float lo, float hi) { return f2bf(lo) | (f2bf(hi) << 16); }
typedef float f32x2_t __attribute__((ext_vector_type(2))); typedef __bf16 bf16x2_t __attribute__((ext_vector_type(2)));
__device__ __forceinline__ unsigned cvtpk(float lo, float hi) { f32x2_t v = {lo, hi}; bf16x2_t b = __builtin_convertvector(v, bf16x2_t); return __builtin_bit_cast(unsigned, b); }
__device__ __forceinline__ float bf2f(bf16 v) { return __uint_as_float((unsigned)v << 16); }
__device__ __forceinline__ int lane_id() { int l; asm volatile("v_mbcnt_lo_u32_b32 %0, -1, 0\n\tv_mbcnt_hi_u32_b32 %0, -1, %0" : "=v"(l)); return l; }
__device__ __forceinline__ float wave_sum(float v) {
#pragma unroll
    for (int o = 1; o < 64; o <<= 1) v += __shfl_xor(v, o);
    return v;
}
__device__ __forceinline__ float swiglu_f(float g, float l) { g = fminf(g, 7.f); l = fminf(fmaxf(l, -7.f), 7.f); return g * __builtin_amdgcn_rcpf(1.f + __expf(-1.702f * g)) * (l + 1.f); }

constexpr size_t MiB = 1u << 20;
constexpr size_t WS_CTL = 0, CTL_ZERO_BYTES = 1 * MiB;
constexpr int CW_BAR = 4096;
constexpr size_t CTL_SS1 = 256 * 1024, CTL_SS2 = 320 * 1024, CTL_CNT = 384 * 1024, CTL_Q = 448 * 1024, CTL_NRM = 480 * 1024, CTL_RDY = 512 * 1024;
constexpr size_t WS_RSTD0 = 1 * MiB;
constexpr size_t WS_GATE = 2 * MiB;
constexpr size_t WS_ROWOF = 3 * MiB;
constexpr size_t WS_TOKOF = 5 * MiB + 512 * 1024;
constexpr size_t WS_LIST = 4 * MiB;
constexpr size_t WS_RS2 = 6 * MiB;
constexpr size_t WS_RG = 7 * MiB;
constexpr size_t WS_WIN_T = 8 * MiB;
constexpr size_t WS_WOUT_T = 15 * MiB;
constexpr size_t WS_WCQ_N = 17 * MiB;
constexpr size_t WS_WCKV_T = 19 * MiB;
constexpr size_t WS_WCO_T = 23 * MiB;
constexpr size_t WS_MN = 25 * MiB;
constexpr size_t WS_MKV = 27 * MiB;
constexpr size_t WS_WQK_T = 31 * MiB;
constexpr size_t WS_WVO_T = 39 * MiB;
constexpr size_t WS_WL = 47 * MiB;
constexpr size_t WS_W1_T = 48 * MiB;
constexpr size_t WS_W2_T = 176 * MiB;
constexpr size_t WS_XB = 240 * MiB;
constexpr size_t WS_PROJ = 272 * MiB;
constexpr size_t WS_Y = 384 * MiB;
constexpr size_t WS_X1 = 416 * MiB;
constexpr size_t WS_X1B = 480 * MiB;
constexpr size_t WS_P = 512 * MiB;
constexpr size_t WS_X2 = 544 * MiB;
constexpr size_t WS_X2B = 608 * MiB;
constexpr size_t WS_XG = 640 * MiB;
constexpr size_t WS_ACT = 784 * MiB;
constexpr size_t WS_END = 928 * MiB;
constexpr size_t WS_RS = 640 * MiB;
constexpr size_t WS_LW = 720 * MiB;
constexpr size_t WS_GG = 832 * MiB;
constexpr size_t WS_OC = 864 * MiB;
constexpr size_t WS_GF = 416 * MiB, WS_HT = 448 * MiB, WS_RF = 512 * MiB, WS_Y0 = 528 * MiB, WS_YRAW = 560 * MiB;
constexpr size_t WS_TMP = 640 * MiB;
namespace pg8 {
#define PG8_LAS __attribute__((address_space(3)))
constexpr int BM = 256, BK = 64, HALF = 128, HTB = HALF * BK * 2  , STAGE_BYTES = 8 * HTB, NXCD = 8, WGM = 8;
__host__ __device__ __forceinline__ int lds_byte(int r, int c) { const int st = (r >> 4) * 2 + (c >> 5), rr = r & 15, cc = c & 31, ob = rr * 64 + cc * 2; return st * 1024 + (ob ^ (((ob >> 9) & 1) << 5)); }
__host__ __device__ __forceinline__ void stage_rc(int b, int& R, int& C) { const int st = b / 1024, sb = b % 1024, swz = sb ^ (((sb >> 9) & 1) << 5); R = (st >> 1) * 16 + swz / 64; C = (st & 1) * 32 + (swz % 64) / 2; }
__host__ __device__ __forceinline__ int perm32(int rho) { const int n = rho >> 4, i = rho & 15; return 8 * (i >> 2) + 4 * n + (i & 3); }

struct Unit { const char* A; const char* B; const int* rows; int row0, col0, z, pad; };

__device__ __forceinline__ void tile_of(int L, int nM, int nN, int& pm, int& pn) {
    const int nwg = nM * nN; int wgid = L; { const int q = nwg / NXCD, r = nwg % NXCD, xcd = wgid % NXCD, off = wgid / NXCD; wgid = (xcd < r ? xcd * (q + 1) : r * (q + 1) + (xcd - r) * q) + off; }
    const int nig = WGM * nN, gid = wgid / nig, fm = gid * WGM, gsz = (nM - fm) < WGM ? (nM - fm) : WGM;
    pm = fm + ((wgid % nig) % gsz); pn = (wgid % nig) / gsz;
}
struct GridSched {
    const char* A; const char* B; int lda, ldb, nM, nN, G, c, first, rows_per_z; size_t zstrideB;
    __device__ __forceinline__ bool next(int i, Unit& u) const {
        const long L = (long)i * G + c - first; if (L < 0 || L >= (long)nM * nN) return false;
        int pm, pn; tile_of((int)L, nM, nN, pm, pn);
        u.row0 = pm * BM; u.col0 = pn * BM; u.z = u.row0 / rows_per_z; u.pad = 0; u.rows = nullptr;
        u.A = A + (size_t)u.row0 * lda * 2; u.B = B + (size_t)u.z * zstrideB + (size_t)u.col0 * ldb * 2; return true; }
    __device__ __forceinline__ void a_ready(const Unit&) const {}
    __device__ __forceinline__ void done(const Unit&) const {}
};
__device__ __forceinline__ unsigned cvt_pk_bf16(float lo, float hi) { unsigned r; asm volatile("v_cvt_pk_bf16_f32 %0, %1, %2" : "=v"(r) : "v"(lo), "v"(hi)); return r; }

#define EPI_ROWS(...) _Pragma("unroll") for (int ai = 0; ai < 2; ++ai) _Pragma("unroll") for (int m = 0; m < 4; ++m) { const int row = u.row0 + ai * HALF + wr * 64 + m * 16 + fr; __VA_ARGS__ }
#define EPI_COLS(...) _Pragma("unroll") for (int bj = 0; bj < 2; ++bj) { const int col = u.col0 + bj * HALF + wc * 32 + 8 * fq; const f32x4 a0 = acc[ai][bj][m][0], a1 = acc[ai][bj][m][1]; __VA_ARGS__ }

struct EpiBf16 {
    static constexpr bool PERM = true, AFTER_DRAIN = false;
    bf16* O; int ldc; const float* rs;
    __device__ __forceinline__ void operator()(const f32x4 (&acc)[2][2][4][2], const Unit& u, int wr, int wc, int fr, int fq) const {
        EPI_ROWS( const float s = rs ? rs[row] : 1.f; bf16* rowp = O + (size_t)row * ldc;
            EPI_COLS( v4u w; w.x = cvt_pk_bf16(a0[0] * s, a0[1] * s); w.y = cvt_pk_bf16(a0[2] * s, a0[3] * s); w.z = cvt_pk_bf16(a1[0] * s, a1[1] * s); w.w = cvt_pk_bf16(a1[2] * s, a1[3] * s);
                      *(v4u*)(rowp + col) = w; ) )
    }
};
struct EpiResid {
    static constexpr bool PERM = true, AFTER_DRAIN = false;
    const float* R; const bf16* Rb; float* Xn; bf16* XnB; float* SS;
    __device__ __forceinline__ void operator()(const f32x4 (&acc)[2][2][4][2], const Unit& u, int wr, int wc, int fr, int fq) const {
        EPI_ROWS( float q = 0.f; const size_t ro = (size_t)row * D;
            EPI_COLS( f32x4 r0, r1;
                      if (R) { r0 = *(const GAS f32x4*)(R + ro + col); r1 = *(const GAS f32x4*)(R + ro + col + 4); }
                      else { const v4u rb = *(const GAS v4u*)(Rb + ro + col); r0 = (f32x4){__uint_as_float(rb.x << 16), __uint_as_float(rb.x & 0xffff0000u), __uint_as_float(rb.y << 16), __uint_as_float(rb.y & 0xffff0000u)};
                             r1 = (f32x4){__uint_as_float(rb.z << 16), __uint_as_float(rb.z & 0xffff0000u), __uint_as_float(rb.w << 16), __uint_as_float(rb.w & 0xffff0000u)}; }
                      const f32x4 x0 = r0 + a0, x1 = r1 + a1;
                      if (Xn) { *(f32x4*)(Xn + ro + col) = x0; *(f32x4*)(Xn + ro + col + 4) = x1; }
                      v4u w; w.x = cvt_pk_bf16(x0[0], x0[1]); w.y = cvt_pk_bf16(x0[2], x0[3]); w.z = cvt_pk_bf16(x1[0], x1[1]); w.w = cvt_pk_bf16(x1[2], x1[3]); *(v4u*)(XnB + ro + col) = w;
                      q += (x0[0] * x0[0] + x0[1] * x0[1]) + (x0[2] * x0[2] + x0[3] * x0[3]) + (x1[0] * x1[0] + x1[1] * x1[1]) + (x1[2] * x1[2] + x1[3] * x1[3]); )
            q += __shfl_xor(q, 16); q += __shfl_xor(q, 32);
            if (fq == 0) atomicAdd(SS + row, q); )
    }
};
struct EpiMoe1 {
    static constexpr bool PERM = true, AFTER_DRAIN = false;
    bf16* ACT; const float* rs; const float* b1;
    __device__ __forceinline__ void operator()(const f32x4 (&acc)[2][2][4][2], const Unit& u, int wr, int wc, int fr, int fq) const {
        EPI_ROWS( const float s = rs[row];
            EPI_COLS( const f32x4 c0 = *(const f32x4*)(b1 + (size_t)u.z * 2 * FF + col), c1 = *(const f32x4*)(b1 + (size_t)u.z * 2 * FF + col + 4);
                      const f32x4 h0 = a0 * s + c0, h1 = a1 * s + c1;
                      v2u w; w.x = cvt_pk_bf16(swiglu_f(h0[0], h0[1]), swiglu_f(h0[2], h0[3])); w.y = cvt_pk_bf16(swiglu_f(h1[0], h1[1]), swiglu_f(h1[2], h1[3]));
                      *(v2u*)(ACT + (size_t)row * FF + (col >> 1)) = w; ) )
    }
};
struct EpiMoe2 {
    static constexpr bool PERM = true, AFTER_DRAIN = false;
    bf16* YE; const float* rg; const float* b2;
    __device__ __forceinline__ void operator()(const f32x4 (&acc)[2][2][4][2], const Unit& u, int wr, int wc, int fr, int fq) const {
        EPI_ROWS( const float s = rg[row];
            EPI_COLS( const f32x4 c0 = *(const f32x4*)(b2 + (size_t)u.z * D + col), c1 = *(const f32x4*)(b2 + (size_t)u.z * D + col + 4);
                      const f32x4 h0 = (a0 + c0) * s, h1 = (a1 + c1) * s;
                      v4u w; w.x = cvt_pk_bf16(h0[0], h0[1]); w.y = cvt_pk_bf16(h0[2], h0[3]); w.z = cvt_pk_bf16(h1[0], h1[1]); w.w = cvt_pk_bf16(h1[2], h1[3]);
                      *(v4u*)(YE + (size_t)row * D + col) = w; ) )
    }
};

struct EpiSoftmax {
    static constexpr bool PERM = true, AFTER_DRAIN = false;
    bf16* O; const float* ss; float c2; PG8_LAS float* x;
    __device__ __forceinline__ void operator()(f32x4 (&acc)[2][2][4][2], const Unit& u, int wr, int wc, int fr, int fq) const {
        PG8_LAS float* MX = x; PG8_LAS float* SX = x + 1024;
        EPI_ROWS( const float s = (1.0f / sqrtf(ss[row] * (1.f / D) + NORM_EPS)) * c2; float mx = -INFINITY;
            _Pragma("unroll") for (int bj = 0; bj < 2; ++bj) _Pragma("unroll") for (int n = 0; n < 2; ++n) { acc[ai][bj][m][n] = acc[ai][bj][m][n] * s; const f32x4 v = acc[ai][bj][m][n]; mx = fmaxf(fmaxf(mx, fmaxf(v[0], v[1])), fmaxf(v[2], v[3])); }
            mx = fmaxf(mx, __shfl_xor(mx, 16)); mx = fmaxf(mx, __shfl_xor(mx, 32));
            if (fq == 0) MX[(ai * HALF + wr * 64 + m * 16 + fr) * 4 + wc] = mx; )
        asm volatile("s_waitcnt lgkmcnt(0)" ::: "memory"); __builtin_amdgcn_s_barrier(); asm volatile("" ::: "memory");
        EPI_ROWS( const f32x4 mm = *(const PG8_LAS f32x4*)(MX + (ai * HALF + wr * 64 + m * 16 + fr) * 4); const float mx = fmaxf(fmaxf(mm[0], mm[1]), fmaxf(mm[2], mm[3])); float l = 0.f;
            _Pragma("unroll") for (int bj = 0; bj < 2; ++bj) _Pragma("unroll") for (int n = 0; n < 2; ++n) { f32x4 v = acc[ai][bj][m][n];
                v[0] = __builtin_amdgcn_exp2f(v[0] - mx); v[1] = __builtin_amdgcn_exp2f(v[1] - mx); v[2] = __builtin_amdgcn_exp2f(v[2] - mx); v[3] = __builtin_amdgcn_exp2f(v[3] - mx); acc[ai][bj][m][n] = v; l += (v[0] + v[1]) + (v[2] + v[3]); }
            l += __shfl_xor(l, 16); l += __shfl_xor(l, 32);
            if (fq == 0) SX[(ai * HALF + wr * 64 + m * 16 + fr) * 4 + wc] = l; (void)row; )
        asm volatile("s_waitcnt lgkmcnt(0)" ::: "memory"); __builtin_amdgcn_s_barrier(); asm volatile("" ::: "memory");
        EPI_ROWS( const f32x4 ll = *(const PG8_LAS f32x4*)(SX + (ai * HALF + wr * 64 + m * 16 + fr) * 4); const float il = 1.0f / ((ll[0] + ll[1]) + (ll[2] + ll[3])); bf16* rowp = O + (size_t)row * D;
            EPI_COLS( v4u w; w.x = cvt_pk_bf16(a0[0] * il, a0[1] * il); w.y = cvt_pk_bf16(a0[2] * il, a0[3] * il); w.z = cvt_pk_bf16(a1[0] * il, a1[1] * il); w.w = cvt_pk_bf16(a1[2] * il, a1[3] * il);
                      *(v4u*)(rowp + col) = w; ) )
    }
};
struct MoeSched {
    const char* A; const char* B; const int* tokof; int lda, ldb, nN, G, c; volatile PG8_LAS unsigned* tab; size_t estrideB;
    __device__ __forceinline__ bool next(int i, Unit& u) const {
        const int total_tiles = (int)tab[64]; int thi = (int)tab[71]; thi = thi < total_tiles ? thi : total_tiles; int tlo = (int)tab[70]; tlo = tlo < thi ? tlo : thi;
        const int U = (thi - tlo) * nN; const long L = (long)i * G + c; if (L >= U) return false;
        int wgid = (int)L; { const int q = U / NXCD, r = U % NXCD, xcd = wgid % NXCD, off = wgid / NXCD; wgid = (xcd < r ? xcd * (q + 1) : r * (q + 1) + (xcd - r) * q) + off; }
        const int lane = lane_id(); const int tb_l = (int)tab[lane & 31] / BM;
        const int cs_l = (tb_l < tlo ? tlo : tb_l > thi ? thi : tb_l) - tlo;
        const unsigned long long mk = __ballot(lane < 32 && cs_l * nN <= wgid);
        const int e = __builtin_amdgcn_readfirstlane(__popcll(mk & 0xffffffffull) - 1);
        const int tb = (int)tab[e] / BM, cnt = (int)tab[32 + e];
        const int te = (cnt + BM - 1) / BM, ts = tb < tlo ? tlo : tb, tend = (tb + te) < thi ? (tb + te) : thi, tce = tend - ts;
        const int idx = wgid - (ts - tlo) * nN, mt = idx % tce, pn = idx / tce;
        u.row0 = (ts + mt) * BM; u.col0 = pn * BM; u.z = e; u.pad = 0; u.rows = tokof ? tokof + u.row0 : nullptr;
        u.A = tokof ? A : A + (size_t)u.row0 * lda * 2; u.B = B + (size_t)e * estrideB + (size_t)u.col0 * ldb * 2; return true; }
    __device__ __forceinline__ void a_ready(const Unit&) const {}
    __device__ __forceinline__ void done(const Unit&) const {}
};
struct FoldSched {
    const char* MKV; const char* W; int mode, G, c, first;
    __device__ __forceinline__ bool next(int i, Unit& u) const {
        const long L = (long)i * G + c - first; if (L < 0 || L >= 64) return false;
        const int z = (int)L >> 2, q = (int)L & 3, b = z >> 2, h = z & 3; u.z = z; u.pad = 0; u.rows = nullptr;
        if (mode == 0) { u.A = MKV + ((size_t)b * MEM * 2 * D + h * 256) * 2; u.B = W + ((size_t)q * 256 * D + h * 256) * 2; u.row0 = b * D + h * 256; u.col0 = q * 256; }
        else { u.A = W + ((size_t)q * 256 * D + h * 256) * 2; u.B = MKV + ((size_t)b * MEM * 2 * D + D + h * 256) * 2; u.row0 = b * D + q * 256; u.col0 = h * 256; }
        return true; }
    __device__ __forceinline__ void a_ready(const Unit&) const {}
    __device__ __forceinline__ void done(const Unit&) const {}
};

template <class Epi, class Sched, bool ALIGN_EPI = false, bool GATHER = false>
__device__ __forceinline__ void gemm_phase(PG8_LAS unsigned char* lds, const int wave_, const int K, const int lda, const int ldb, const Sched& S, const Epi& E) {
    constexpr bool SP2 = true;
    const int lane = lane_id(), wid = wave_, tid = wid * 64 + lane, wr = wid >> 2, wc = wid & 3, fr = lane & 15, fq = lane >> 4;
    int nt = K / BK; asm volatile("" : "+s"(nt));
    unsigned voffA[2], voffB[2];
#pragma unroll
    for (int i = 0; i < 2; ++i) { int R, C; stage_rc(tid * 16 + i * 8192, R, C); const int Rb = Epi::PERM ? ((R & ~31) + perm32(R & 31)) : R;
        voffA[i] = (unsigned)(R * lda + C) * 2u; voffB[i] = (unsigned)(Rb * ldb + C) * 2u; }
    int gR[2], gC[2];
#pragma unroll
    for (int i = 0; i < 2; ++i) { int R, C; stage_rc(tid * 16 + i * 8192, R, C); gR[i] = R; gC[i] = C * 2; }
    PG8_LAS int* gtab = (PG8_LAS int*)(lds + STAGE_BYTES + 1024);
    const size_t kstep = (size_t)(BK * 2);
    const size_t hstepA = (size_t)HALF * lda * 2, hstepB = (size_t)HALF * ldb * 2;
    const unsigned ldsw = (unsigned)wid * 1024u;
    const int aoff = lds_byte(wr * 64 + fr, fq * 8), boff = lds_byte(wc * 32 + fr, fq * 8);
#define PG8_SA(b, h) (((b) * 2 + (h)) * HTB)
#define PG8_SB(b, h) ((4 + (b) * 2 + (h)) * HTB)
#define PG8_STAGE(bufoff, gbase, voff) do { _Pragma("unroll") for (int _i = 0; _i < 2; ++_i) \
        __builtin_amdgcn_global_load_lds((const unsigned*)((const char*)(gbase) + (voff)[_i]), (PG8_LAS unsigned*)(lds + (bufoff) + ldsw + _i * 8192), 16, 0, 0); } while (0)
#define PG8_STAGE_A(bufoff, gbase, h, tsel) do { if constexpr (GATHER) { _Pragma("unroll") for (int _i = 0; _i < 2; ++_i) { const unsigned _o = (unsigned)gtab[(tsel) * 256 + (h) * 128 + gR[_i]] * (unsigned)(lda * 2) + (unsigned)gC[_i]; \
        __builtin_amdgcn_global_load_lds((const unsigned*)((const char*)(gbase) + _o), (PG8_LAS unsigned*)(lds + (bufoff) + ldsw + _i * 8192), 16, 0, 0); } } \
    else { _Pragma("unroll") for (int _i = 0; _i < 2; ++_i) __builtin_amdgcn_global_load_lds((const unsigned*)((const char*)(gbase) + (h) * hstepA + voffA[_i]), (PG8_LAS unsigned*)(lds + (bufoff) + ldsw + _i * 8192), 16, 0, 0); } } while (0)
#define PG8_LDA(dst, b, h) do { _Pragma("unroll") for (int m = 0; m < 4; ++m) _Pragma("unroll") for (int k = 0; k < 2; ++k) dst[m][k] = *(const PG8_LAS bf16x8*)(lds + PG8_SA(b, h) + aoff + m * 2048 + k * 1024); } while (0)
#define PG8_LDB(dst, b, h) do { _Pragma("unroll") for (int n = 0; n < 2; ++n) _Pragma("unroll") for (int k = 0; k < 2; ++k) dst[n][k] = *(const PG8_LAS bf16x8*)(lds + PG8_SB(b, h) + boff + n * 2048 + k * 1024); } while (0)
#define PG8_MMA(ai, bj, At, Bt) do { __builtin_amdgcn_s_setprio(1); _Pragma("unroll") for (int m = 0; m < 4; ++m) _Pragma("unroll") for (int n = 0; n < 2; ++n) _Pragma("unroll") for (int k = 0; k < 2; ++k) \
        acc[ai][bj][m][n] = __builtin_amdgcn_mfma_f32_16x16x32_bf16(Bt[n][k], At[m][k], acc[ai][bj][m][n], 0, 0, 0); __builtin_amdgcn_s_setprio(0); } while (0)
#define PG8_WAIT_V(n) asm volatile("s_waitcnt vmcnt(" #n ")" ::: "memory")
#define PG8_WAIT_L(n) asm volatile("s_waitcnt lgkmcnt(" #n ")" ::: "memory")
#define PG8_BAR __builtin_amdgcn_s_barrier()
#define PG8_SCHED __builtin_amdgcn_sched_barrier(0)
    Unit cur, nxt; int ui = 0;
    if (!S.next(0, cur)) return;
    f32x4 acc[2][2][4][2];
#pragma unroll
    for (int a = 0; a < 2; ++a)
#pragma unroll
        for (int b = 0; b < 2; ++b)
#pragma unroll
            for (int m = 0; m < 4; ++m)
#pragma unroll
                for (int n = 0; n < 2; ++n) acc[a][b][m][n] = (f32x4){0.f, 0.f, 0.f, 0.f};
    bf16x8 At[4][2], B0[2][2], B1[2][2];
    const char* cA = cur.A; const char* cB = cur.B;
    int tc = 0;
    if constexpr (GATHER) { if (tid < 256) gtab[tid] = cur.rows[tid]; asm volatile("s_waitcnt lgkmcnt(0)" ::: "memory"); PG8_BAR; }
    S.a_ready(cur);
    if constexpr (SP2) {
        PG8_STAGE(PG8_SB(0, 0), cB, voffB); PG8_STAGE(PG8_SB(0, 1), cB + hstepB, voffB); PG8_STAGE_A(PG8_SA(0, 0), cA, 0, tc); PG8_STAGE_A(PG8_SA(0, 1), cA, 1, tc);
        if (wr == 1) PG8_BAR;
        PG8_WAIT_V(2); PG8_BAR;
        PG8_STAGE(PG8_SB(1, 0), cB + kstep, voffB); PG8_STAGE_A(PG8_SA(1, 0), cA + kstep, 0, tc); PG8_STAGE(PG8_SB(1, 1), cB + hstepB + kstep, voffB);
        PG8_WAIT_V(6); PG8_BAR;
    }
    for (;;) {
        const bool has_next = S.next(ui + 1, nxt);
        if constexpr (GATHER) { if (has_next && tid < 256) gtab[(tc ^ 1) * 256 + tid] = nxt.rows[tid]; }
        const char* nA = has_next ? nxt.A : cA; const char* nB = has_next ? nxt.B : cB;
        for (int t = 0; t < nt; t += 2) {
            const bool last = (t == nt - 2); const int tl = (last && has_next) ? (tc ^ 1) : tc;
            const char* a1 = cA + (size_t)(t + 1) * kstep;
            const char* a2 = last ? nA : cA + (size_t)(t + 2) * kstep; const char* b2 = last ? nB : cB + (size_t)(t + 2) * kstep;
            const char* a3 = a2 + kstep; const char* b3 = b2 + kstep;
            if (last && has_next) S.a_ready(nxt);
            if constexpr (SP2) {
            PG8_LDB(B0, 0, 0); PG8_LDB(B1, 0, 1); PG8_SCHED; PG8_LDA(At, 0, 0); PG8_STAGE_A(PG8_SA(1, 1), a1, 1, tc);
            PG8_WAIT_V(8); PG8_WAIT_L(0); PG8_BAR; PG8_MMA(0, 0, At, B0); PG8_MMA(0, 1, At, B1); PG8_BAR; PG8_SCHED;
            PG8_LDA(At, 0, 1); PG8_STAGE(PG8_SB(0, 0), b2, voffB); PG8_STAGE(PG8_SB(0, 1), b2 + hstepB, voffB); PG8_STAGE_A(PG8_SA(0, 0), a2, 0, tl);
            PG8_WAIT_V(8); PG8_WAIT_L(0); PG8_BAR; PG8_MMA(1, 0, At, B0); PG8_MMA(1, 1, At, B1); PG8_BAR; PG8_SCHED;
            PG8_LDB(B0, 1, 0); PG8_LDB(B1, 1, 1); PG8_SCHED; PG8_LDA(At, 1, 0); PG8_STAGE_A(PG8_SA(0, 1), a2, 1, tl);
            PG8_WAIT_V(8); PG8_WAIT_L(0); PG8_BAR; PG8_MMA(0, 0, At, B0); PG8_MMA(0, 1, At, B1); PG8_BAR; PG8_SCHED;
            PG8_LDA(At, 1, 1); PG8_STAGE(PG8_SB(1, 0), b3, voffB); PG8_STAGE(PG8_SB(1, 1), b3 + hstepB, voffB); PG8_STAGE_A(PG8_SA(1, 0), a3, 0, tl);
            PG8_WAIT_V(8); PG8_WAIT_L(0); PG8_BAR; PG8_MMA(1, 0, At, B0); PG8_MMA(1, 1, At, B1); PG8_BAR; PG8_SCHED;
            }
        }
        if constexpr (ALIGN_EPI) { if (wr == 0) PG8_BAR; }
        if constexpr (!Epi::AFTER_DRAIN) { E(acc, cur, wr, wc, fr, fq); S.done(cur); }
        if (!has_next) break;
#pragma unroll
        for (int a = 0; a < 2; ++a)
#pragma unroll
            for (int b = 0; b < 2; ++b)
#pragma unroll
                for (int m = 0; m < 4; ++m)
#pragma unroll
                    for (int n = 0; n < 2; ++n) acc[a][b][m][n] = (f32x4){0.f, 0.f, 0.f, 0.f};
        cur = nxt; cA = nA; cB = nB; ++ui; tc ^= 1;
        if constexpr (ALIGN_EPI) { if (wr == 1) PG8_BAR; }
    }
    PG8_WAIT_V(0);
    if constexpr (!ALIGN_EPI) { if (wr == 0) PG8_BAR; }
    PG8_BAR;
    if constexpr (Epi::AFTER_DRAIN) { E.fused(acc, cur, wr, wc, fr, fq, lds, wid, lane); S.done(cur); }
#undef PG8_SA
#undef PG8_SB
#undef PG8_STAGE
#undef PG8_STAGE_A
#undef PG8_LDA
#undef PG8_LDB
#undef PG8_MMA
#undef PG8_WAIT_V
#undef PG8_WAIT_L
#undef PG8_BAR
#undef PG8_SCHED
}
}
#define XB_TMO      128
#define XB_XCNT(j)  (256  + 64 * (j))
#define XB_XSUB(j)  (1280 + 64 * (j))
#define XB_XGEN(j)  (2304 + 64 * (j))
#define XB_TOP      3328
#define XB_TOPGEN   3392
#define XCD_BAR_WORDS 3456
#define XB_SPIN_CAP (1u << 24)

__device__ __forceinline__ unsigned xb_ld(unsigned* p)              { return __hip_atomic_load(p, __ATOMIC_RELAXED, __HIP_MEMORY_SCOPE_AGENT); }
__device__ __forceinline__ unsigned xb_add(unsigned* p, unsigned v) { return __hip_atomic_fetch_add(p, v, __ATOMIC_RELAXED, __HIP_MEMORY_SCOPE_AGENT); }
__device__ __forceinline__ unsigned xb_xcc_id() { return (unsigned)__builtin_amdgcn_s_getreg((3 << 11) | 20) & 0xFu; }
#define XB_SPIN(cond, bar) do { unsigned _sp = 0; while (cond) { __builtin_amdgcn_s_sleep(1); \
    if ((++_sp & 255u) == 0u) { if (xb_ld(&(bar)[XB_TMO])) break; if (_sp > XB_SPIN_CAP) { atomicAdd(&(bar)[XB_TMO], 1u); break; } } } } while (0)

struct XcdBarrier {
    unsigned* bar; unsigned x;
    volatile LAS unsigned* st;
};

__device__ __forceinline__ XcdBarrier xcd_barrier_post(unsigned* bar, volatile LAS unsigned* st, int wave_) {
    XcdBarrier b; b.bar = bar; b.x = xb_xcc_id(); b.st = st;
    if (wave_ == 0 && lane_id() == 0) (void)xb_add(&bar[XB_XCNT(b.x)], 1u);
    return b;
}
__device__ __forceinline__ void xcd_barrier_complete(unsigned* bar, unsigned x, unsigned& nloc, unsigned& nx) {
    const unsigned G = gridDim.x * gridDim.y * gridDim.z;
    unsigned sum, cnt, mine, sp = 0u;
    for (;;) {
        sum = 0u; cnt = 0u; mine = 0u;
#pragma unroll
        for (unsigned j = 0; j < 16; ++j) { const unsigned c = xb_ld(&bar[XB_XCNT(j)]); sum += c; cnt += (c > 0u) ? 1u : 0u; mine = (j == x) ? c : mine; }
        if (sum == G) break;
        __builtin_amdgcn_s_sleep(1);
        if ((++sp & 255u) == 0u) { if (xb_ld(&bar[XB_TMO])) break; if (sp > XB_SPIN_CAP) { atomicAdd(&bar[XB_TMO], 1u); break; } }
    }
    nloc = mine > 0u ? mine : 1u; nx = cnt > 0u ? cnt : 1u;
}

__device__ __forceinline__ void xcd_barrier(const XcdBarrier& b, int wave_) {
    asm volatile("s_waitcnt vmcnt(0)" ::: "memory");
    __syncthreads();
    if (wave_ == 0 && lane_id() == 0) {
        unsigned* bar = b.bar;
        __builtin_amdgcn_s_waitcnt(0);
        unsigned nloc = b.st[0], nx = b.st[1];
        if (nloc == 0u) { xcd_barrier_complete(bar, b.x, nloc, nx); b.st[0] = nloc; b.st[1] = nx; }
        const unsigned old = xb_add(&bar[XB_XSUB(b.x)], 1u);
        const unsigned gen = old / nloc;
        if (old + 1u == (gen + 1u) * nloc) {
            __builtin_amdgcn_fence(__ATOMIC_RELEASE, "agent");
            asm volatile("s_waitcnt vmcnt(0)" ::: "memory");
            const unsigned og = xb_add(&bar[XB_TOP], 1u);
            const unsigned tg = og / nx;
            if (og + 1u == (tg + 1u) * nx) xb_add(&bar[XB_TOPGEN], 1u);
            else XB_SPIN(xb_ld(&bar[XB_TOPGEN]) == tg, bar);
            __builtin_amdgcn_fence(__ATOMIC_ACQUIRE, "agent");
            xb_add(&bar[XB_XGEN(b.x)], 1u);
            asm volatile("s_waitcnt vmcnt(0)" ::: "memory");
        } else {
            XB_SPIN(xb_ld(&bar[XB_XGEN(b.x)]) == gen, bar);
            __builtin_amdgcn_fence(__ATOMIC_ACQUIRE, "agent");
            asm volatile("s_waitcnt vmcnt(0)" ::: "memory");
        }
    }
    __syncthreads();
}
__device__ __forceinline__ void split_arrive(unsigned* cnt, int wave_) {
    asm volatile("s_waitcnt vmcnt(0)" ::: "memory"); __syncthreads();
    if (wave_ == 0 && lane_id() == 0) { __builtin_amdgcn_fence(__ATOMIC_RELEASE, "agent"); asm volatile("s_waitcnt vmcnt(0)" ::: "memory"); (void)xb_add(cnt, 1u); }
}
__device__ __forceinline__ void split_wait(unsigned* cnt, unsigned n, unsigned* bar, int wave_) {
    if (wave_ == 0 && lane_id() == 0) { XB_SPIN(xb_ld(cnt) < n, bar); __builtin_amdgcn_fence(__ATOMIC_ACQUIRE, "agent"); asm volatile("s_waitcnt vmcnt(0)" ::: "memory"); }
    __syncthreads();
}
constexpr int RING_OFF = 0, RING_BYTES = 131072;
constexpr int LDS_BYTES = 163840;
constexpr int LDSCTL_OFF = LDS_BYTES - 2048, MISC_OFF = LDSCTL_OFF + 320;
constexpr int EPIX_OFF = RING_BYTES + 1024;

struct Frame {
    LAS unsigned char* lds;
    volatile LAS unsigned* MISC;
    gu32* ctl;
    int tid, lane, wave;
    int vcu, G;
    int gw, NGW, gt, NGT;
};
__device__ __forceinline__ void refresh(Frame& F) {
    int lane = lane_id();
#if REFRESH_OPAQUE
    asm volatile("" : "+v"(lane));
#endif
    const int tid = F.wave * 64 + lane; F.tid = tid; F.lane = lane;
    F.gw = F.vcu * NWAVES + F.wave; F.NGW = F.G * NWAVES; F.gt = F.vcu * NTHR + tid; F.NGT = F.G * NTHR;
}
struct Args { const float* in[34]; float* out; unsigned char* ws; int ph_lo, ph_hi, li, pad; };

__device__ __forceinline__ void p0_transpose_item(const float* W, int ldw, int K, int N, const float* rowg, bf16* WT, LAS float* scr, int item, int lane, int qlo = 0, int qhi = 0, float qs = 1.f) {
    const int nblk = N / 32, kb = item / nblk, nb = item % nblk, k0 = 64 * kb, n0 = 32 * nb;
    {
        const int kr = lane >> 3, nc = (lane & 7) * 4;
#pragma unroll
        for (int j = 0; j < 8; ++j) { const int kk = 8 * j + kr; f32x4 v = *(const f32x4*)(W + (size_t)(k0 + kk) * ldw + n0 + nc); const float g = (rowg ? rowg[k0 + kk] : 1.f) * ((n0 >= qlo && n0 < qhi) ? qs : 1.f);
            scr[kk * 33 + nc] = v[0] * g; scr[kk * 33 + nc + 1] = v[1] * g; scr[kk * 33 + nc + 2] = v[2] * g; scr[kk * 33 + nc + 3] = v[3] * g; }
    }
    LDS_WAIT(); asm volatile("" ::: "memory");
    const int c = lane & 7;
#pragma unroll
    for (int j = 0; j < 4; ++j) { const int n = (lane >> 3) + 8 * j; const LAS float* s = scr + (8 * c) * 33 + n;
        v4u o; o.x = pk2(s[0 * 33], s[1 * 33]); o.y = pk2(s[2 * 33], s[3 * 33]); o.z = pk2(s[4 * 33], s[5 * 33]); o.w = pk2(s[6 * 33], s[7 * 33]);
        *(GAS v4u*)(WT + (size_t)(n0 + n) * K + k0 + 8 * c) = o; }
    LDS_WAIT(); asm volatile("" ::: "memory");
}
struct TItem { const GAS float* W; GAS bf16* WT; const GAS float* rowg; int ldw, K, k0, n0; };
__device__ __forceinline__ void p0_t_load(const TItem& t, f32x4 (&v)[8], float (&g)[8], int lane) {
    const int kr = lane >> 3, nc = (lane & 7) * 4;
#pragma unroll
    for (int j = 0; j < 8; ++j) { const int kk = 8 * j + kr; v[j] = __builtin_nontemporal_load((const GAS f32x4*)(t.W + (size_t)(t.k0 + kk) * t.ldw + t.n0 + nc)); g[j] = t.rowg ? t.rowg[t.k0 + kk] : 1.f; }
}
__device__ __forceinline__ void p0_t_finish(const TItem& t, const f32x4 (&v)[8], const float (&g)[8], LAS float* scr, int lane) {
    const int kr = lane >> 3, nc = (lane & 7) * 4;
#pragma unroll
    for (int j = 0; j < 8; ++j) { const int kk = 8 * j + kr; scr[kk * 33 + nc] = v[j][0] * g[j]; scr[kk * 33 + nc + 1] = v[j][1] * g[j]; scr[kk * 33 + nc + 2] = v[j][2] * g[j]; scr[kk * 33 + nc + 3] = v[j][3] * g[j]; }
    LDS_WAIT(); asm volatile("" ::: "memory");
    const int c = lane & 7;
#pragma unroll
    for (int j = 0; j < 4; ++j) { const int n = (lane >> 3) + 8 * j; const LAS float* s = scr + (8 * c) * 33 + n;
        v4u o; o.x = cvtpk(s[0 * 33], s[1 * 33]); o.y = cvtpk(s[2 * 33], s[3 * 33]); o.z = cvtpk(s[4 * 33], s[5 * 33]); o.w = cvtpk(s[6 * 33], s[7 * 33]);
        __builtin_nontemporal_store(o, (GAS v4u*)(t.WT + (size_t)(t.n0 + n) * t.K + t.k0 + 8 * c)); }
    LDS_WAIT(); asm volatile("" ::: "memory");
}
__device__ __forceinline__ void row_to_bf16(int lane, const float* xrow, bf16* orow, const float* g, bool normalise, float* rstd_out) {
    const GAS f32x4* xr = (const GAS f32x4*)xrow + lane;
    f32x4 v[4]; float s = 0.f;
#pragma unroll
    for (int j = 0; j < 4; ++j) { v[j] = xr[64 * j]; s += (v[j].x * v[j].x + v[j].y * v[j].y) + (v[j].z * v[j].z + v[j].w * v[j].w); }
    const float rstd = 1.0f / sqrtf(wave_sum(s) * (1.f / D) + NORM_EPS);
    if (rstd_out && lane == 0) *rstd_out = rstd;
    GAS unsigned long long* o8 = (GAS unsigned long long*)orow + lane;
#pragma unroll
    for (int j = 0; j < 4; ++j) { f32x4 w = v[j];
        if (normalise) { const f32x4 gg = *((const f32x4*)g + lane + 64 * j); w = w * rstd * gg; }
        o8[64 * j] = (unsigned long long)pk2(w.x, w.y) | ((unsigned long long)pk2(w.z, w.w) << 32); }
}

struct RefG { const bf16* A; long lda; const bf16* Bt; long ldb; int M, N, K; };
template <class Epi> __device__ __forceinline__ void ref_gemm(Frame& F, const RefG g, const Epi& epi) {
    LAS float* As = (LAS float*)(F.lds); LAS float* Bs = As + 16 * 132;
    const int tx = F.tid & 15, ty = F.tid >> 4;
    const int tm = (g.M + 127) / 128, tn = g.N / 64;
    for (int tile = F.vcu; tile < tm * tn; tile += F.G) {
        const int m0 = (tile / tn) * 128, n0 = (tile % tn) * 64;
        float acc[4][4];
#pragma unroll
        for (int i = 0; i < 4; ++i)
#pragma unroll
            for (int j = 0; j < 4; ++j) acc[i][j] = 0.f;
        for (int k0 = 0; k0 < g.K; k0 += 16) {
            { const int idx = F.tid * 4, r = idx >> 4, kk = idx & 15, row = m0 + r;
#pragma unroll
              for (int j = 0; j < 4; ++j) As[(kk + j) * 132 + r] = row < g.M ? bf2f(g.A[(long)row * g.lda + k0 + kk + j]) : 0.f; }
            { const int idx = F.tid * 2, cc = idx >> 4, kk = idx & 15;
#pragma unroll
              for (int j = 0; j < 2; ++j) Bs[(kk + j) * 68 + cc] = bf2f(g.Bt[(long)(n0 + cc) * g.ldb + k0 + kk + j]); }
            __syncthreads();
#pragma unroll
            for (int kk = 0; kk < 16; ++kk) { float a[4], b[4];
#pragma unroll
                for (int i = 0; i < 4; ++i) a[i] = As[kk * 132 + ty * 4 + i];
#pragma unroll
                for (int j = 0; j < 4; ++j) b[j] = Bs[kk * 68 + tx * 4 + j];
#pragma unroll
                for (int i = 0; i < 4; ++i)
#pragma unroll
                    for (int j = 0; j < 4; ++j) acc[i][j] += a[i] * b[j]; }
            __syncthreads();
        }
#pragma unroll
        for (int i = 0; i < 4; ++i) { const int row = m0 + ty * 4 + i; if (row < g.M) epi(row, n0 + tx * 4, acc[i]); }
    }
}

#define RLF(x, j) __int_as_float(__builtin_amdgcn_readlane(__float_as_int(x), (j)))
namespace attn_body {
typedef ::bf16 bf16;
using bf16x8=__attribute__((ext_vector_type(8)))short;
using s16x4=__attribute__((ext_vector_type(4)))short;
using f32x16=__attribute__((ext_vector_type(16)))float;
using u32x4=__attribute__((ext_vector_type(4)))unsigned;
constexpr int SEQ=::SEQ,D=64,DM=::PROJ_LD,DO=512;
constexpr int NW=8,QBLK=32,QB=QBLK*NW,KVBLK=64,NQB=SEQ/QB;
__device__ __forceinline__ int crow(int r,int hi){return (r&3)+8*(r>>2)+4*hi;}
#define SBAR() __builtin_amdgcn_sched_barrier(0)
__device__ __forceinline__ void cmask(f32x16&p0,f32x16&p1,int jb,int qrel,int hi){
  const float NEG=-INFINITY; int qd=qrel-(64*jb+4*hi); asm volatile("":"+v"(qd));
  #pragma unroll
  for(int r=0;r<16;++r){const int c=(r&3)+8*(r>>2); if(c>qd)p0[r]=NEG; if(c+32>qd)p1[r]=NEG;}
}

constexpr int NSLOT=3, SLOTB=8192;
constexpr int LDS_K=0, LDS_V=NSLOT*SLOTB, LDS_WS=3*NSLOT*SLOTB, LDS_OST=LDS_WS+NW*64*4, LDS_BYTES=LDS_OST+NW*4096;
constexpr float C2=0.125f*1.4426950408889634f;
__device__ __forceinline__ void glds16(const void*gsrc,unsigned lds_dst){unsigned keep;
  asm volatile("s_mov_b32 %0, m0\n\ts_mov_b32 m0, %2\n\ts_nop 0\n\tglobal_load_lds_dwordx4 %1, off\n\ts_mov_b32 m0, %0":"=&s"(keep):"v"(gsrc),"s"(lds_dst):"memory");}
__device__ __forceinline__ float max3f(float a,float b,float c){float r;asm("v_max3_f32 %0, %1, %2, %3":"=v"(r):"v"(a),"v"(b),"v"(c));return r;}
__device__ __forceinline__ float max2f(float a,float b){float r;asm("v_max_f32_e32 %0, %1, %2":"=v"(r):"v"(a),"v"(b));return r;}
__device__ __forceinline__ float fadd_s(float a,float b){float r;asm("v_add_f32_e32 %0, %1, %2":"=v"(r):"v"(a),"v"(b));return r;}
__device__ __forceinline__ float fsub_s(float a,float b){float r;asm("v_sub_f32_e32 %0, %1, %2":"=v"(r):"v"(a),"v"(b));return r;}
typedef float f32x2_t __attribute__((ext_vector_type(2))); typedef __bf16 bf16x2_t __attribute__((ext_vector_type(2)));
__device__ __forceinline__ unsigned cvtpk_s(float lo,float hi){f32x2_t v={lo,hi};bf16x2_t b=__builtin_convertvector(v,bf16x2_t);return __builtin_bit_cast(unsigned,b);}
#define WAIT_BAR(N) asm volatile("s_waitcnt vmcnt(" #N ") lgkmcnt(0)\n\ts_barrier":::"memory")

__device__ __forceinline__ void qkt(f32x16&p0,f32x16&p1,const char*Kslot,const bf16x8*qr,int r32,int hi){
  const char*kb=Kslot+hi*1024+r32*16;
  #pragma unroll
  for(int d0=0;d0<4;++d0){
    const bf16x8 b0=*reinterpret_cast<const bf16x8*>(kb+d0*2048);
    const bf16x8 b1=*reinterpret_cast<const bf16x8*>(kb+d0*2048+512);
    if(d0==0){p0=__builtin_amdgcn_mfma_f32_32x32x16_bf16(b0,qr[0],f32x16{},0,0,0);p1=__builtin_amdgcn_mfma_f32_32x32x16_bf16(b1,qr[0],f32x16{},0,0,0);}
    else{p0=__builtin_amdgcn_mfma_f32_32x32x16_bf16(b0,qr[d0],p0,0,0,0);p1=__builtin_amdgcn_mfma_f32_32x32x16_bf16(b1,qr[d0],p1,0,0,0);}}
}
typedef __attribute__((address_space(3))) const char* lds_cptr;
typedef short v4i16_t __attribute__((ext_vector_type(4)));
__device__ __forceinline__ void kload8(bf16x8*kf,lds_cptr kp){
  kf[0]=*(const __attribute__((address_space(3))) bf16x8*)(kp);      kf[1]=*(const __attribute__((address_space(3))) bf16x8*)(kp+512);
  kf[2]=*(const __attribute__((address_space(3))) bf16x8*)(kp+2048); kf[3]=*(const __attribute__((address_space(3))) bf16x8*)(kp+2560);
  kf[4]=*(const __attribute__((address_space(3))) bf16x8*)(kp+4096); kf[5]=*(const __attribute__((address_space(3))) bf16x8*)(kp+4608);
  kf[6]=*(const __attribute__((address_space(3))) bf16x8*)(kp+6144); kf[7]=*(const __attribute__((address_space(3))) bf16x8*)(kp+6656);
}
__device__ __forceinline__ void kload2(bf16x8*kf,lds_cptr kp,int j){ kf[2*j]=*(const __attribute__((address_space(3))) bf16x8*)(kp+j*2048); kf[2*j+1]=*(const __attribute__((address_space(3))) bf16x8*)(kp+j*2048+512); }
__device__ __forceinline__ s16x4 vtr(lds_cptr p){ return __builtin_bit_cast(s16x4,__builtin_amdgcn_ds_read_tr16_b64_v4i16((__attribute__((address_space(3))) v4i16_t*)p)); }
__device__ __forceinline__ float rowmax(const f32x16&p0,const f32x16&p1){
  float a=max3f(p0[0],p0[1],p1[0]),b=max3f(p0[2],p0[3],p1[1]);a=max3f(a,p1[2],p1[3]);
  #pragma unroll
  for(int r=4;r<16;r+=4){a=max3f(a,p0[r],p0[r+1]);b=max3f(b,p0[r+2],p0[r+3]);a=max3f(a,p1[r],p1[r+1]);b=max3f(b,p1[r+2],p1[r+3]);}
  const float m=max2f(a,b);
  auto rr=__builtin_amdgcn_permlane32_swap(__float_as_uint(m),__float_as_uint(m),false,false);
  return max2f(__uint_as_float(rr[0]),__uint_as_float(rr[1]));
}
__device__ __forceinline__ void pv(f32x16*o,int vb,bf16x8 pa0,bf16x8 pa1,bf16x8 pa2,bf16x8 pa3){
  #pragma unroll
  for(int d0=0;d0<4;++d0){s16x4 lo[4],hi[4];
    #pragma unroll
    for(int ks=0;ks<4;++ks){
      asm volatile("ds_read_b64_tr_b16 %0,%1 offset:%c2":"=&v"(lo[ks]):"v"(vb),"i"(d0*4096+ks*1024):"memory");
      asm volatile("ds_read_b64_tr_b16 %0,%1 offset:%c2":"=&v"(hi[ks]):"v"(vb),"i"(d0*4096+ks*1024+512):"memory");}
    asm volatile("s_waitcnt lgkmcnt(0)":::"memory");SBAR();
    #define PK(k) (bf16x8){lo[k][0],lo[k][1],lo[k][2],lo[k][3],hi[k][0],hi[k][1],hi[k][2],hi[k][3]}
    o[d0]=__builtin_amdgcn_mfma_f32_32x32x16_bf16(pa0,PK(0),o[d0],0,0,0);
    o[d0]=__builtin_amdgcn_mfma_f32_32x32x16_bf16(pa1,PK(1),o[d0],0,0,0);
    o[d0]=__builtin_amdgcn_mfma_f32_32x32x16_bf16(pa2,PK(2),o[d0],0,0,0);
    o[d0]=__builtin_amdgcn_mfma_f32_32x32x16_bf16(pa3,PK(3),o[d0],0,0,0);
    #undef PK
  }
}

#ifndef ATTN_STORE16
#define ATTN_STORE16(p,v) (*(u32x4*)(p)=(v))
#endif
template<int THRL> __device__ __forceinline__ void attn_unit(int wave_,int qb,int tstart,const bf16*Qh,const bf16*__restrict__ Kh,const bf16*__restrict__ Vh,bf16*Oh,float beta,char*shm){
  const int lane=lane_id(),r32=lane&31,hi=lane>>5; const int wid=wave_;
  const int q0=qb*QB;
  const bf16*Qw=Qh+(long)(q0+wid*QBLK)*DM;
  const unsigned lds0=(unsigned)(uintptr_t)shm;
  float*wsf=(float*)(shm+LDS_WS)+wid*64;
  const bf16*ksrc=Kh+(long)(lane+tstart*KVBLK)*DM+wid*8;
  const bf16*vsrc=Vh+(long)(16*(wid&3)+(lane>>2)+tstart*KVBLK)*DM+(wid>>2)*32+(lane&3)*8;
  const unsigned kdst=lds0+LDS_K+wid*1024, vdst=lds0+LDS_V+wid*1024;
  #define DMA_K(t,slot) glds16(ksrc+(long)(t)*KVBLK*DM,(unsigned)__builtin_amdgcn_readfirstlane(kdst+(slot)))
  #define DMA_V(t,slot) do{ glds16(vsrc+(long)(t)*KVBLK*DM,(unsigned)__builtin_amdgcn_readfirstlane(vdst+2*(slot))); glds16(vsrc+64+(long)(t)*KVBLK*DM,(unsigned)__builtin_amdgcn_readfirstlane(vdst+2*(slot)+SLOTB)); }while(0)
  const int vb0=(int)(lds0+LDS_V)+((lane>>4)&1)*32+(lane&3)*8+(4*hi+((lane&15)>>2))*64;
  const char*Kbase=shm+LDS_K; bf16x8 kf[8];
  const lds_cptr shm3=(lds_cptr)shm; const lds_cptr kp0=shm3+LDS_K+hi*1024+r32*16; const lds_cptr vp0=shm3+LDS_V+((lane>>4)&1)*32+(lane&3)*8+(4*hi+((lane&15)>>2))*64;
  const int NT=(q0+QB)/KVBLK-tstart;
  DMA_K(0,0);DMA_V(0,0);DMA_K(1,SLOTB);
  bf16x8 qr[4];
  #pragma unroll
  for(int d0=0;d0<4;++d0)qr[d0]=*reinterpret_cast<const bf16x8*>(&Qw[(long)r32*DM+d0*16+hi*8]);
  const unsigned one2=(hi==0)?0x3F803F80u:0u; bf16x8 qaug=__builtin_bit_cast(bf16x8,(u32x4){one2,one2,0u,0u});
  #define QAUG_UPDATE() do{ float b_=-mhat; unsigned t1=f2bf(b_); b_-=__uint_as_float(t1<<16); unsigned t2=f2bf(b_); b_-=__uint_as_float(t2<<16); unsigned t3=f2bf(b_); b_-=__uint_as_float(t3<<16); unsigned t4=f2bf(b_); \
      unsigned w2_=t1|(t2<<16), w3_=t3|(t4<<16); if(hi){w2_=0u;w3_=0u;} qaug=__builtin_bit_cast(bf16x8,(u32x4){one2,one2,w2_,w3_}); }while(0)
  #define KAUG(dst,t,half) do{ float b_=beta*(float)(64*((t)+tstart)+32*(half)+r32-q0); unsigned w0_,w1_; \
      { unsigned t1=f2bf(b_); b_-=__uint_as_float(t1<<16); unsigned t2=f2bf(b_); b_-=__uint_as_float(t2<<16); unsigned t3=f2bf(b_); b_-=__uint_as_float(t3<<16); unsigned t4=f2bf(b_); w0_=t1|(t2<<16); w1_=t3|(t4<<16);} \
      if(hi){w0_=0u;w1_=0u;} dst=__builtin_bit_cast(bf16x8,(u32x4){w0_,w1_,one2,one2}); }while(0)
  float mhat=beta*(float)(wid*QBLK+r32),l_reg=0.f;f32x16 o[4];o[0]=f32x16{};o[1]=f32x16{};o[2]=f32x16{};o[3]=f32x16{};
  QAUG_UPDATE();
  const int qrel=wid*QBLK+r32;
  #define CMASK(P0,P1,t) do{int jb_=(t)-(NT-4); if(jb_>=0)cmask(P0,P1,jb_,qrel,hi);}while(0)
  bool resc=false;
  #define START(P0,P1) do{ const float rm=rowmax(P0,P1); resc=false; \
    { const float dl=max2f(rm,0.f); mhat=fadd_s(mhat,dl); \
      _Pragma("unroll") for(int r=0;r<16;++r){P0[r]=fsub_s(P0[r],dl);P1[r]=fsub_s(P1[r],dl);} \
      QAUG_UPDATE(); } \
    _Pragma("unroll") for(int r=0;r<16;++r)P0[r]=__builtin_amdgcn_exp2f(P0[r]); }while(0)
  #define RESC() do{ if(resc){ asm volatile("s_waitcnt lgkmcnt(0)":::"memory"); \
      _Pragma("unroll") for(int d_=0;d_<4;++d_) _Pragma("unroll") for(int r=0;r<16;++r)o[d_][r]*=wsf[crow(r,hi)]; } }while(0)
  f32x16 pA0,pA1,pB0,pB1;
  int sl_prev=0,sl_cur=0,sl_next=SLOTB;
  #define ROT() do{sl_prev=sl_cur;sl_cur=sl_next;sl_next=(sl_next==(NSLOT-1)*SLOTB)?0:sl_next+SLOTB;}while(0)
  DMA_K(2,2*SLOTB);
  WAIT_BAR(4);
  qkt(pA0,pA1,Kbase,qr,r32,hi);
  { bf16x8 ka0,ka1; KAUG(ka0,0,0); KAUG(ka1,0,1); pA0=__builtin_amdgcn_mfma_f32_32x32x16_bf16(ka0,qaug,pA0,0,0,0); pA1=__builtin_amdgcn_mfma_f32_32x32x16_bf16(ka1,qaug,pA1,0,0,0); }
  asm volatile("s_nop 15\n\ts_nop 7":"+v"(pA0),"+v"(pA1));CMASK(pA0,pA1,0);
  START(pA0,pA1);
  _Pragma("unroll") for(int r=0;r<16;++r)pA1[r]=__builtin_amdgcn_exp2f(pA1[r]);
  WAIT_BAR(0);
  DMA_K(3,0);DMA_V(1,SLOTB);
  ROT();
  kload8(kf,kp0+sl_cur);
  WAIT_BAR(3);
  s16x4 vlo[4],vhi[4]; u32x4 pw0,pw1,pw2,pw3;
  #define PKW(P,B) cvtpk_s(P[B],P[B+1])
  #define PAF(k) __builtin_bit_cast(bf16x8,pw##k)
  #define VFR(i) (bf16x8){vlo[i][0],vlo[i][1],vlo[i][2],vlo[i][3],vhi[i][0],vhi[i][1],vhi[i][2],vhi[i][3]}
  #define PIN(x) asm volatile("":"+v"(x))
  #define MX3(a,b,c) __builtin_fmaxf(__builtin_fmaxf((a),(b)),(c))
  #define GAPA(MF,A0,A1,A2,A3,W0,W1,PW) do{ MF; sacc+=A0; sacc+=A1; sacc+=A2; sacc+=A3; PIN(sacc); W0; W1; PIN(PW); SBAR(); }while(0)
  #define EX(v) __builtin_amdgcn_exp2f(v)
  #define GAPB(MF,X,B) do{ MF; X[B]=EX(X[B]); X[B+1]=EX(X[B+1]); PIN(X); SBAR(); }while(0)
  #define VRD(j) do{ vlo[(j)&3]=vtr(vp_+(((j)&3)*4096+((j)>>2)*1024)); vhi[(j)&3]=vtr(vp_+(((j)&3)*4096+((j)>>2)*1024+512)); }while(0)
  #define KRD(G,j) do{ if(G){ kload2(kf,kp0+sl_next,j); SBAR(); } }while(0)
  #define STEP(C0,C1,P0,P1,t,GK,GV,GL) do{ SBAR(); \
    const lds_cptr vp_=vp0+2*sl_prev; \
    VRD(0); SBAR(); float sacc=(P0[0]+P0[1]); \
    GAPA(C0=__builtin_amdgcn_mfma_f32_32x32x16_bf16(kf[0],qr[0],f32x16{},0,0,0), P0[2],P0[3],P0[4],P0[5],     pw0[0]=PKW(P0,0), pw0[1]=PKW(P0,2), pw0); \
    VRD(1); SBAR(); GAPA(C1=__builtin_amdgcn_mfma_f32_32x32x16_bf16(kf[1],qr[0],f32x16{},0,0,0), P0[6],P0[7],P0[8],P0[9],     pw0[2]=PKW(P0,4), pw0[3]=PKW(P0,6), pw0); \
    VRD(2); SBAR(); GAPA(C0=__builtin_amdgcn_mfma_f32_32x32x16_bf16(kf[2],qr[1],C0,0,0,0),   P0[10],P0[11],P0[12],P0[13], pw1[0]=PKW(P0,8), pw1[1]=PKW(P0,10), pw1); \
    VRD(3); SBAR(); GAPA(C1=__builtin_amdgcn_mfma_f32_32x32x16_bf16(kf[3],qr[1],C1,0,0,0),   P0[14],P0[15],P1[0],P1[1],   pw1[2]=PKW(P0,12),pw1[3]=PKW(P0,14), pw1); \
    GAPA(C0=__builtin_amdgcn_mfma_f32_32x32x16_bf16(kf[4],qr[2],C0,0,0,0),   P1[2],P1[3],P1[4],P1[5],     pw2[0]=PKW(P1,0), pw2[1]=PKW(P1,2), pw2); \
    GAPA(C1=__builtin_amdgcn_mfma_f32_32x32x16_bf16(kf[5],qr[2],C1,0,0,0),   P1[6],P1[7],P1[8],P1[9],     pw2[2]=PKW(P1,4), pw2[3]=PKW(P1,6), pw2); \
    GAPA(C0=__builtin_amdgcn_mfma_f32_32x32x16_bf16(kf[6],qr[3],C0,0,0,0),   P1[10],P1[11],P1[12],P1[13], pw3[0]=PKW(P1,8), pw3[1]=PKW(P1,10), pw3); \
    GAPA(C1=__builtin_amdgcn_mfma_f32_32x32x16_bf16(kf[7],qr[3],C1,0,0,0),   P1[14],P1[15],0.f,0.f,       pw3[2]=PKW(P1,12),pw3[3]=PKW(P1,14), pw3); \
    { bf16x8 ka0_,ka1_; KAUG(ka0_,t,0); KAUG(ka1_,t,1); C0=__builtin_amdgcn_mfma_f32_32x32x16_bf16(ka0_,qaug,C0,0,0,0); C1=__builtin_amdgcn_mfma_f32_32x32x16_bf16(ka1_,qaug,C1,0,0,0); } \
    l_reg+=sacc; \
    if(GK){DMA_K((t)+3,sl_cur);} if(GV){DMA_V((t)+1,sl_next);} \
    CMASK(C0,C1,t); \
    { float a=MX3(C0[0],C0[1],C1[0]),b=MX3(C0[2],C0[3],C1[1]); a=MX3(a,C1[2],C1[3]); \
      _Pragma("unroll") for(int r=4;r<16;r+=4){a=MX3(a,C0[r],C0[r+1]);b=MX3(b,C0[r+2],C0[r+3]);a=MX3(a,C1[r],C1[r+1]);b=MX3(b,C1[r+2],C1[r+3]);} \
      float rm=__builtin_fmaxf(a,b); { auto rr=__builtin_amdgcn_permlane32_swap(__float_as_uint(rm),__float_as_uint(rm),false,false); rm=__builtin_fmaxf(__uint_as_float(rr[0]),__uint_as_float(rr[1])); } \
      resc=false; \
      if(__builtin_expect(__any(rm>(float)THRL),0)){ const float dl=__builtin_fmaxf(rm,0.f); mhat+=dl; \
        _Pragma("unroll") for(int r=0;r<16;++r){C0[r]-=dl;C1[r]-=dl;} \
        QAUG_UPDATE(); \
        const float f=__builtin_amdgcn_exp2f(-dl); l_reg*=f; if(hi==0)wsf[r32]=f; resc=true; } } \
    SBAR(); \
    GAPB(o[0]=__builtin_amdgcn_mfma_f32_32x32x16_bf16(PAF(0),VFR(0),o[0],0,0,0), C0,0); VRD(4); SBAR(); \
    GAPB(o[1]=__builtin_amdgcn_mfma_f32_32x32x16_bf16(PAF(0),VFR(1),o[1],0,0,0), C0,2); VRD(5); SBAR(); \
    KRD(GL,0); GAPB(o[2]=__builtin_amdgcn_mfma_f32_32x32x16_bf16(PAF(0),VFR(2),o[2],0,0,0), C0,4); VRD(6); SBAR(); \
    KRD(GL,1); GAPB(o[3]=__builtin_amdgcn_mfma_f32_32x32x16_bf16(PAF(0),VFR(3),o[3],0,0,0), C0,6); VRD(7); SBAR(); \
    KRD(GL,2); GAPB(o[0]=__builtin_amdgcn_mfma_f32_32x32x16_bf16(PAF(1),VFR(0),o[0],0,0,0), C0,8); VRD(8); SBAR(); \
    KRD(GL,3); GAPB(o[1]=__builtin_amdgcn_mfma_f32_32x32x16_bf16(PAF(1),VFR(1),o[1],0,0,0), C0,10); VRD(9); SBAR(); \
    GAPB(o[2]=__builtin_amdgcn_mfma_f32_32x32x16_bf16(PAF(1),VFR(2),o[2],0,0,0), C0,12); VRD(10); SBAR(); \
    GAPB(o[3]=__builtin_amdgcn_mfma_f32_32x32x16_bf16(PAF(1),VFR(3),o[3],0,0,0), C0,14); VRD(11); SBAR(); \
    GAPB(o[0]=__builtin_amdgcn_mfma_f32_32x32x16_bf16(PAF(2),VFR(0),o[0],0,0,0), C1,0); VRD(12); SBAR(); \
    GAPB(o[1]=__builtin_amdgcn_mfma_f32_32x32x16_bf16(PAF(2),VFR(1),o[1],0,0,0), C1,2); VRD(13); SBAR(); \
    GAPB(o[2]=__builtin_amdgcn_mfma_f32_32x32x16_bf16(PAF(2),VFR(2),o[2],0,0,0), C1,4); VRD(14); SBAR(); \
    GAPB(o[3]=__builtin_amdgcn_mfma_f32_32x32x16_bf16(PAF(2),VFR(3),o[3],0,0,0), C1,6); VRD(15); SBAR(); \
    GAPB(o[0]=__builtin_amdgcn_mfma_f32_32x32x16_bf16(PAF(3),VFR(0),o[0],0,0,0), C1,8); \
    GAPB(o[1]=__builtin_amdgcn_mfma_f32_32x32x16_bf16(PAF(3),VFR(1),o[1],0,0,0), C1,10); \
    GAPB(o[2]=__builtin_amdgcn_mfma_f32_32x32x16_bf16(PAF(3),VFR(2),o[2],0,0,0), C1,12); \
    GAPB(o[3]=__builtin_amdgcn_mfma_f32_32x32x16_bf16(PAF(3),VFR(3),o[3],0,0,0), C1,14); \
    }while(0)
  int t=1;
  #undef CMASK
  #define CMASK(P0,P1,t) do{}while(0)
  for(;t+5<NT;t+=2){
    STEP(pB0,pB1,pA0,pA1,t,true,true,true);     WAIT_BAR(3); RESC(); ROT();
    STEP(pA0,pA1,pB0,pB1,t+1,true,true,true);   WAIT_BAR(3); RESC(); ROT();
  }
  #undef CMASK
  #define CMASK(P0,P1,t) do{int jb_=(t)-(NT-4); if(jb_>=0)cmask(P0,P1,jb_,qrel,hi);}while(0)
  #define ENDW(tt) do{ if((tt)+3<NT){WAIT_BAR(3);} else if((tt)+2<NT){WAIT_BAR(2);} else {WAIT_BAR(0);} }while(0)
  for(;t+1<NT;t+=2){
    STEP(pB0,pB1,pA0,pA1,t,(t+3<NT),(t+1<NT),(t+1<NT));       ENDW(t);   RESC(); ROT();
    STEP(pA0,pA1,pB0,pB1,t+1,(t+4<NT),(t+2<NT),(t+2<NT));     ENDW(t+1); RESC(); ROT();
  }
  STEP(pB0,pB1,pA0,pA1,NT-1,false,false,false); RESC();
  { float sacc=pB0[0]+pB0[1]; _Pragma("unroll") for(int r=2;r<16;++r)sacc+=pB0[r]; _Pragma("unroll") for(int r=0;r<16;++r)sacc+=pB1[r]; l_reg+=sacc;
    pw0=(u32x4){PKW(pB0,0),PKW(pB0,2),PKW(pB0,4),PKW(pB0,6)};pw1=(u32x4){PKW(pB0,8),PKW(pB0,10),PKW(pB0,12),PKW(pB0,14)};pw2=(u32x4){PKW(pB1,0),PKW(pB1,2),PKW(pB1,4),PKW(pB1,6)};pw3=(u32x4){PKW(pB1,8),PKW(pB1,10),PKW(pB1,12),PKW(pB1,14)};
    SBAR(); pv(o,vb0+2*sl_cur,PAF(0),PAF(1),PAF(2),PAF(3)); }
  #undef PKW
  #undef PAF
  #undef VFR
  #undef PIN
  #undef MX3
  #undef GAPA
  #undef GAPB
  #undef EX
  #undef VRD
  #undef KRD
  #undef STEP
  #undef ENDW
  {auto rr=__builtin_amdgcn_permlane32_swap(__float_as_uint(l_reg),__float_as_uint(l_reg),false,false);l_reg=__uint_as_float(rr[0])+__uint_as_float(rr[1]);}
  if(hi==0)wsf[32+r32]=l_reg;asm volatile("s_waitcnt lgkmcnt(0)":::"memory");
  float rli[16];
  #pragma unroll
  for(int r=0;r<16;++r)rli[r]=__builtin_amdgcn_rcpf(wsf[32+crow(r,hi)]);
  bf16*Ow=Oh+(long)(q0+wid*QBLK)*DO;
  { bf16*stg=(bf16*)(shm+LDS_OST)+wid*2048;
    #pragma unroll
    for(int ps=0;ps<2;++ps){
      #pragma unroll
      for(int r=0;r<16;++r){const int orow=crow(r,hi);
        #pragma unroll
        for(int d0=0;d0<2;++d0)stg[orow*64+d0*32+r32]=(bf16)f2bf(o[2*ps+d0][r]*rli[r]);}
      asm volatile("s_waitcnt lgkmcnt(0)":::"memory");
      #pragma unroll
      for(int i=0;i<4;++i){const int row=i*8+(lane>>3),ch=lane&7; const u32x4 v=*(const u32x4*)(stg+row*64+ch*8); ATTN_STORE16(Ow+(long)row*DO+ps*64+ch*8,v);}
      asm volatile("s_waitcnt lgkmcnt(0)":::"memory"); } }
  asm volatile("s_waitcnt lgkmcnt(0)\n\ts_barrier":::"memory");
  #undef KAUG
  #undef QAUG_UPDATE
  #undef DMA_K
  #undef DMA_V
  #undef CMASK
  #undef START
  #undef RESC
  #undef ROT
}
constexpr int ATTN_LDS_BYTES=LDS_BYTES;
#undef SBAR
#undef WAIT_BAR
}
namespace rwkv {
typedef float f32x16 __attribute__((ext_vector_type(16)));
constexpr int L = 32, NCH = SEQ / L;
constexpr int AR_STRIDE = 144, TI_STRIDE = 64;
constexpr int O_A0 = 0, O_A1 = 4608, O_BK = 9216, O_MAK = 9216, O_MRB = 11264, O_MRK = 13312, O_W = 15360, O_AT = 15360, O_UT = 15360, O_VT = 0, O_BT = 4608, O_KT = 9216;
constexpr int WAVE_LDS = 19456;
__device__ __forceinline__ int crow(int r, int h) { return (r & 3) + 8 * (r >> 2) + 4 * h; }
__device__ __forceinline__ unsigned pkbf(float lo, float hi) { return cvtpk(lo, hi); }
__device__ __forceinline__ unsigned short bf1(float x) { return (unsigned short)cvtpk(x, 0.f); }
__device__ __forceinline__ bf16x8 frag(const LAS unsigned char* img, int stride, int row, int s, int h) { return *(const LAS bf16x8*)(img + row * stride + (16 * s + 8 * h) * 2); }
__device__ __forceinline__ bf16x8 packfrag(const f32x16& a, int s) { v4u w; w.x = pkbf(a[8 * s], a[8 * s + 1]); w.y = pkbf(a[8 * s + 2], a[8 * s + 3]); w.z = pkbf(a[8 * s + 4], a[8 * s + 5]); w.w = pkbf(a[8 * s + 6], a[8 * s + 7]); return __builtin_bit_cast(bf16x8, w); }
#define RWKV_MFMA(a, b, c) __builtin_amdgcn_mfma_f32_32x32x16_bf16(a, b, c, 0, 0, 0)
#define LDS_FENCE() asm volatile("s_waitcnt lgkmcnt(0)" ::: "memory")

struct ChunkBufs { unsigned char* GF; unsigned char* HT; unsigned char* RF; unsigned char* Y0; };

__device__ __forceinline__ void stage1_chunk(LAS unsigned char* lw, const ChunkBufs& cb, int ch, const bf16* Rr, const float* Wr, const bf16* Kr, const bf16* Vr, const bf16* KKr, const bf16* KKAr, int lane) {
    asm volatile("" : "+v"(lane));
    const int bh = ch / NCH, cidx = ch % NCH, b = bh >> 3, hd = bh & 7; const int r32 = lane & 31, h = lane >> 5;
    const size_t row0 = (size_t)b * SEQ + (size_t)cidx * L; const int col = hd * 64 + lane;
    float Xa[32]; unsigned vpk[16], bpk[16], kpk[16];
    float g = 0.f, eg = 1.f;
    float ldv[2][8][6];
#define S1_LOAD(buf, t0_) do { _Pragma("unroll") for (int u = 0; u < 8; ++u) { const size_t o = (row0 + (t0_) + u) * C + col; \
        ldv[buf][u][0] = bf2f(Rr[o]); ldv[buf][u][1] = Wr[o]; ldv[buf][u][2] = bf2f(Kr[o]); ldv[buf][u][3] = bf2f(KKr[o]); ldv[buf][u][4] = bf2f(KKAr[o]); ldv[buf][u][5] = bf2f(Vr[o]); } } while (0)
    S1_LOAD(0, 0);
#pragma unroll
    for (int tg = 0; tg < 4; ++tg) {
        asm volatile("" ::: "memory");
        if (tg < 3) { if (tg & 1) S1_LOAD(0, 8 * tg + 8); else S1_LOAD(1, 8 * tg + 8); }
#pragma unroll
        for (int u2 = 0; u2 < 8; u2 += 2) { const int t = 8 * tg + u2;
            float ah[2], rh[2], bh_[2], kh[2], vv[2];
#pragma unroll
            for (int u = 0; u < 2; ++u) { const float* lv = ldv[tg & 1][u2 + u];
                const float r = lv[0], w = lv[1], k = lv[2], kk = lv[3], kka = lv[4]; vv[u] = lv[5];
                const float egp = eg; g += w  ; eg = __expf(g); const float einv = __builtin_amdgcn_rcpf(eg);
                ah[u] = -kk * egp; rh[u] = r * eg; bh_[u] = kka * einv; kh[u] = k * einv; Xa[t + u] = ah[u]; }
            const unsigned pa = pkbf(ah[0], ah[1]), pr = pkbf(rh[0], rh[1]), pb = pkbf(bh_[0], bh_[1]), pk = pkbf(kh[0], kh[1]);
            vpk[t >> 1] = pkbf(vv[0], vv[1]); bpk[t >> 1] = pb; kpk[t >> 1] = pk;
            *(LAS unsigned short*)(lw + O_A0 + t * AR_STRIDE + lane * 2) = (unsigned short)pa; *(LAS unsigned short*)(lw + O_A0 + (t + 1) * AR_STRIDE + lane * 2) = (unsigned short)(pa >> 16);
            *(LAS unsigned short*)(lw + O_A1 + t * AR_STRIDE + lane * 2) = (unsigned short)pr; *(LAS unsigned short*)(lw + O_A1 + (t + 1) * AR_STRIDE + lane * 2) = (unsigned short)(pr >> 16);
            *(LAS unsigned short*)(lw + O_BK + t * AR_STRIDE + lane * 2) = (unsigned short)pb; *(LAS unsigned short*)(lw + O_BK + (t + 1) * AR_STRIDE + lane * 2) = (unsigned short)(pb >> 16);
            *(LAS unsigned short*)(lw + O_BK + (32 + t) * AR_STRIDE + lane * 2) = (unsigned short)pk; *(LAS unsigned short*)(lw + O_BK + (33 + t) * AR_STRIDE + lane * 2) = (unsigned short)(pk >> 16);
        }
    }
#undef S1_LOAD
    const float egL = eg;
    LDS_FENCE();
    f32x16 mab = {}, mak = {}, mrb = {}, mrk = {};
#pragma unroll
    for (int s = 0; s < 4; ++s) {
        const bf16x8 fa = frag(lw + O_A0, AR_STRIDE, r32, s, h), fr = frag(lw + O_A1, AR_STRIDE, r32, s, h);
        const bf16x8 fb = frag(lw + O_BK, AR_STRIDE, r32, s, h), fk = frag(lw + O_BK, AR_STRIDE, 32 + r32, s, h);
        mab = RWKV_MFMA(fa, fb, mab); mak = RWKV_MFMA(fa, fk, mak); mrb = RWKV_MFMA(fr, fb, mrb); mrk = RWKV_MFMA(fr, fk, mrk);
    }
    const float fd = (float)(r32 - 4 * h);
#pragma unroll
    for (int r = 0; r < 16; ++r) { const float dtj = (float)crow(r, 0) - fd; const float fs = fminf(fmaxf(dtj, 0.f), 1.f), fi = fminf(fmaxf(dtj + 1.f, 0.f), 1.f);
        mab[r] *= fs; mak[r] *= fs; mrb[r] *= fi; mrk[r] *= fi;
    }
    LDS_FENCE();
#pragma unroll
    for (int r = 0; r < 16; ++r) { const int t = crow(r, h);
        *(LAS unsigned short*)(lw + O_MAK + t * TI_STRIDE + r32 * 2) = bf1(mak[r]);
        *(LAS unsigned short*)(lw + O_MRB + t * TI_STRIDE + r32 * 2) = bf1(mrb[r]);
        *(LAS unsigned short*)(lw + O_MRK + t * TI_STRIDE + r32 * 2) = bf1(mrk[r]);
    }
#pragma unroll
    for (int q = 0; q < 4; ++q) *(LAS v4u*)(lw + O_VT + lane * TI_STRIDE + 16 * q) = (v4u){vpk[4 * q], vpk[4 * q + 1], vpk[4 * q + 2], vpk[4 * q + 3]};
    LDS_FENCE();
    float Xu[32];
#pragma unroll
    for (int ct = 0; ct < 2; ++ct) {
        f32x16 w0 = {};
#pragma unroll
        for (int s = 0; s < 2; ++s) w0 = RWKV_MFMA(frag(lw + O_MAK, TI_STRIDE, r32, s, h), frag(lw + O_VT, TI_STRIDE, ct * 32 + r32, s, h), w0);
#pragma unroll
        for (int r = 0; r < 16; ++r) *(LAS float*)(lw + O_W + crow(r, h) * 128 + r32 * 4) = w0[r];
        LDS_FENCE();
        if (h == ct) {
#pragma unroll
            for (int t = 0; t < L; ++t) Xu[t] = *(const LAS float*)(lw + O_W + t * 128 + r32 * 4); }
        LDS_FENCE();
    }
#pragma unroll
    for (int t = 1; t < L; ++t) {
        const int rt = (t & 3) + 4 * (t >> 3), ht = (t >> 2) & 1;
        float xa = Xa[t], xu = Xu[t];
#pragma unroll
        for (int j = 0; j < t; ++j) { const float n = __int_as_float(__builtin_amdgcn_readlane(__float_as_int(mab[rt]), j + 32 * ht)); xa += n * Xa[j]; xu += n * Xu[j]; }
        Xa[t] = xa; Xu[t] = xu;
    }
#pragma unroll
    for (int q = 0; q < 4; ++q) *(LAS v4u*)(lw + O_AT + lane * TI_STRIDE + 16 * q) = (v4u){pkbf(Xa[8 * q], Xa[8 * q + 1]), pkbf(Xa[8 * q + 2], Xa[8 * q + 3]), pkbf(Xa[8 * q + 4], Xa[8 * q + 5]), pkbf(Xa[8 * q + 6], Xa[8 * q + 7])};
    LDS_FENCE();
#pragma unroll
    for (int rt = 0; rt < 2; ++rt) { f32x16 a;
#pragma unroll
        for (int r = 0; r < 16; ++r) a[r] = __uint_as_float((unsigned)*(const LAS unsigned short*)(lw + O_A1 + r32 * AR_STRIDE + (rt * 32 + crow(r, h)) * 2) << 16);
#pragma unroll
        for (int s = 0; s < 2; ++s) a = RWKV_MFMA(frag(lw + O_AT, TI_STRIDE, rt * 32 + r32, s, h), frag(lw + O_MRB, TI_STRIDE, r32, s, h), a);
#pragma unroll
        for (int s = 0; s < 2; ++s) *(bf16x8*)(cb.RF + (size_t)ch * 4096 + ((rt * 2 + s) * 64 + lane) * 16) = packfrag(a, s);
    }
    LDS_FENCE();
#pragma unroll
    for (int q = 0; q < 4; ++q) { v4u wb;
#pragma unroll
        for (int e = 0; e < 4; ++e) { const unsigned pb = bpk[4 * q + e]; wb[e] = pkbf(__uint_as_float(pb << 16) * egL, __uint_as_float(pb & 0xffff0000u) * egL); }
        *(LAS v4u*)(lw + O_BT + lane * TI_STRIDE + 16 * q) = wb; }
    LDS_FENCE();
#pragma unroll
    for (int ct = 0; ct < 2; ++ct) { const float egc = __shfl(egL, ct * 32 + r32);
#pragma unroll
        for (int rt = 0; rt < 2; ++rt) { f32x16 a = {};
#pragma unroll
            for (int s = 0; s < 2; ++s) a = RWKV_MFMA(frag(lw + O_AT, TI_STRIDE, rt * 32 + r32, s, h), frag(lw + O_BT, TI_STRIDE, ct * 32 + r32, s, h), a);
            if (rt == ct) {
#pragma unroll
                for (int r = 0; r < 16; ++r) { const float dtj = (float)crow(r, 0) - fd; a[r] += egc * (fminf(fmaxf(dtj + 1.f, 0.f), 1.f) - fminf(fmaxf(dtj, 0.f), 1.f)); } }
#pragma unroll
            for (int s = 0; s < 2; ++s) *(bf16x8*)(cb.GF + (size_t)ch * 8192 + (((ct * 2 + rt) * 2 + s) * 64 + lane) * 16) = packfrag(a, s);
        } }
    LDS_FENCE();
#pragma unroll
    for (int q = 0; q < 4; ++q) *(LAS v4u*)(lw + O_UT + lane * TI_STRIDE + 16 * q) = (v4u){pkbf(Xu[8 * q], Xu[8 * q + 1]), pkbf(Xu[8 * q + 2], Xu[8 * q + 3]), pkbf(Xu[8 * q + 4], Xu[8 * q + 5]), pkbf(Xu[8 * q + 6], Xu[8 * q + 7])};
    LDS_FENCE();
#pragma unroll
    for (int ct = 0; ct < 2; ++ct) { f32x16 a = {};
#pragma unroll
        for (int s = 0; s < 2; ++s) { a = RWKV_MFMA(frag(lw + O_MRB, TI_STRIDE, r32, s, h), frag(lw + O_UT, TI_STRIDE, ct * 32 + r32, s, h), a);
                                      a = RWKV_MFMA(frag(lw + O_MRK, TI_STRIDE, r32, s, h), frag(lw + O_VT, TI_STRIDE, ct * 32 + r32, s, h), a); }
        unsigned char* dst = cb.Y0 + (size_t)ch * 4096 + (ct * 64 + lane) * 32;
#pragma unroll
        for (int q = 0; q < 2; ++q) *(v4u*)(dst + 16 * q) = (v4u){pkbf(a[8 * q], a[8 * q + 1]), pkbf(a[8 * q + 2], a[8 * q + 3]), pkbf(a[8 * q + 4], a[8 * q + 5]), pkbf(a[8 * q + 6], a[8 * q + 7])};
    }
    LDS_FENCE();
#pragma unroll
    for (int q = 0; q < 4; ++q) { v4u wk;
#pragma unroll
        for (int e = 0; e < 4; ++e) { const unsigned pk = kpk[4 * q + e]; wk[e] = pkbf(__uint_as_float(pk << 16) * egL, __uint_as_float(pk & 0xffff0000u) * egL); }
        *(LAS v4u*)(lw + O_KT + lane * TI_STRIDE + 16 * q) = wk; }
    LDS_FENCE();
#pragma unroll
    for (int rt = 0; rt < 2; ++rt)
#pragma unroll
        for (int ct = 0; ct < 2; ++ct) { f32x16 a = {};
#pragma unroll
            for (int s = 0; s < 2; ++s) { a = RWKV_MFMA(frag(lw + O_BT, TI_STRIDE, rt * 32 + r32, s, h), frag(lw + O_UT, TI_STRIDE, ct * 32 + r32, s, h), a);
                                          a = RWKV_MFMA(frag(lw + O_KT, TI_STRIDE, rt * 32 + r32, s, h), frag(lw + O_VT, TI_STRIDE, ct * 32 + r32, s, h), a); }
            unsigned char* dst = cb.HT + (size_t)ch * 8192 + ((rt * 2 + ct) * 64 + lane) * 32;
#pragma unroll
            for (int q = 0; q < 2; ++q) *(v4u*)(dst + 16 * q) = (v4u){pkbf(a[8 * q], a[8 * q + 1]), pkbf(a[8 * q + 2], a[8 * q + 3]), pkbf(a[8 * q + 4], a[8 * q + 5]), pkbf(a[8 * q + 6], a[8 * q + 7])};
        }
    LDS_FENCE();
}

struct S2Ops { bf16x8 G[2][2][2], R[2][2]; f32x16 n0, n1; const unsigned char* yp; };
__device__ __forceinline__ void s2_load(S2Ops& o, const ChunkBufs& cb, size_t ch, int iblk, int lane) {
    const unsigned char* g0 = cb.GF + ch * 8192 + lane * 16; const unsigned char* g1 = g0 + 4096; const unsigned char* rp = cb.RF + ch * 4096 + lane * 16;
    const unsigned char* h0 = cb.HT + ch * 8192 + (iblk * 64 + lane) * 32; const unsigned char* h1 = h0 + 4096; const unsigned char* yp = cb.Y0 + ch * 4096 + (iblk * 64 + lane) * 32;
    o.yp = yp;
#pragma unroll
    for (int bq = 0; bq < 2; ++bq)
#pragma unroll
        for (int s = 0; s < 2; ++s) { o.G[0][bq][s] = *(const bf16x8*)(g0 + (bq * 2 + s) * 1024); o.G[1][bq][s] = *(const bf16x8*)(g1 + (bq * 2 + s) * 1024); o.R[bq][s] = *(const bf16x8*)(rp + (bq * 2 + s) * 1024); }
#pragma unroll
    for (int q = 0; q < 2; ++q) { const v4u v0 = *(const v4u*)(h0 + 16 * q), v1 = *(const v4u*)(h1 + 16 * q);
#pragma unroll
        for (int e = 0; e < 4; ++e) { o.n0[8 * q + 2 * e] = __uint_as_float(v0[e] << 16); o.n0[8 * q + 2 * e + 1] = __uint_as_float(v0[e] & 0xffff0000u); o.n1[8 * q + 2 * e] = __uint_as_float(v1[e] << 16); o.n1[8 * q + 2 * e + 1] = __uint_as_float(v1[e] & 0xffff0000u); } }
}
__device__ __forceinline__ void s2_step(S2Ops& o, const bf16x8 (&sf)[2][2], float* yo, int h) {
    f32x16 y;
#pragma unroll
    for (int q = 0; q < 2; ++q) { const v4u vy = *(const v4u*)(o.yp + 16 * q);
#pragma unroll
        for (int e = 0; e < 4; ++e) { y[8 * q + 2 * e] = __uint_as_float(vy[e] << 16); y[8 * q + 2 * e + 1] = __uint_as_float(vy[e] & 0xffff0000u); } }
#pragma unroll
    for (int bq = 0; bq < 2; ++bq)
#pragma unroll
        for (int s = 0; s < 2; ++s) { o.n0 = RWKV_MFMA(o.G[0][bq][s], sf[bq][s], o.n0); o.n1 = RWKV_MFMA(o.G[1][bq][s], sf[bq][s], o.n1); }
#pragma unroll
    for (int bq = 0; bq < 2; ++bq)
#pragma unroll
        for (int s = 0; s < 2; ++s) y = RWKV_MFMA(o.R[bq][s], sf[bq][s], y);
#pragma unroll
    for (int r = 0; r < 16; ++r) yo[(size_t)crow(r, h) * C] = y[r];
}
__device__ __forceinline__ void stage2(const ChunkBufs& cb, int bh, int iblk, float* YRAW, int lane) {
    const int r32 = lane & 31, h = lane >> 5, b = bh >> 3, hd = bh & 7;
    float* yo = YRAW + (size_t)b * SEQ * C + hd * 64 + iblk * 32 + r32;
    const size_t ch0 = (size_t)bh * NCH;
    S2Ops A, B; A.n0 = f32x16{}; A.n1 = f32x16{};
    s2_load(B, cb, ch0, iblk, lane);
#pragma unroll 1
    for (int c = 0; c < NCH; c += 2) {
        bf16x8 sf[2][2];
#pragma unroll
        for (int s = 0; s < 2; ++s) { sf[0][s] = packfrag(A.n0, s); sf[1][s] = packfrag(A.n1, s); }
        s2_load(A, cb, ch0 + c + 1, iblk, lane);
        s2_step(B, sf, yo + (size_t)c * L * C, h);
#pragma unroll
        for (int s = 0; s < 2; ++s) { sf[0][s] = packfrag(B.n0, s); sf[1][s] = packfrag(B.n1, s); }
        if (c + 2 < NCH) s2_load(B, cb, ch0 + c + 2, iblk, lane);
        s2_step(A, sf, yo + (size_t)(c + 1) * L * C, h);
    }
}
#undef RWKV_MFMA
#undef LDS_FENCE
}
#ifndef MK_REPEAT_PHASE
#define MK_REPEAT_PHASE -1
#endif
#ifndef ATTN_SKIP
#define ATTN_SKIP 1
#endif
#ifndef CONV_EIGHTHS
#define CONV_EIGHTHS 3
#endif
#ifndef OPT_GEMM
#define OPT_GEMM 1
#endif
#ifndef OPT_ATTN
#define OPT_ATTN 1
#endif
#ifndef OPT_PREP
#define OPT_PREP 1
#endif
#ifndef OPT_ROUTER
#define OPT_ROUTER 1
#endif
#ifndef MOE_SPLIT
#define MOE_SPLIT 1
#endif
#ifndef PROBE_LATE_P1
#define PROBE_LATE_P1 0
#endif

__global__ void __launch_bounds__(NTHR, 2) mk_fwd(Args args) {
    extern __shared__ __attribute__((aligned(16))) unsigned char lds[];
    Frame F;
    F.lds = (LAS unsigned char*)lds;
    F.MISC = (volatile LAS unsigned*)(F.lds + MISC_OFF);
    F.wave = __builtin_amdgcn_readfirstlane((int)threadIdx.x >> 6); F.lane = lane_id(); F.tid = F.wave * 64 + F.lane;
    F.G = gridDim.x; { const int bx = blockIdx.x; F.vcu = (F.G % 8 == 0) ? (bx % 8) * (F.G / 8) + bx / 8 : bx; }
    F.ctl = (gu32*)(args.ws + WS_CTL);
    for (int u = F.tid; u < (LDS_BYTES - LDSCTL_OFF) / 4; u += NTHR) ((LAS unsigned*)(F.lds + LDSCTL_OFF))[u] = 0u;
    __syncthreads();
    XcdBarrier bar = xcd_barrier_post((unsigned*)(F.ctl + CW_BAR) + args.li * 4096, F.MISC + 8, F.wave);
    const int lo = args.ph_lo, hi = args.ph_hi;
#define IN(k) (lo <= (k) && (k) < hi)
#define SEAM(k) do { if (IN(k) && IN((k) + 1)) xcd_barrier(bar, F.wave); } while (0)
    const __attribute__((address_space(4))) unsigned char* ka = (const __attribute__((address_space(4))) unsigned char*)__builtin_amdgcn_kernarg_segment_ptr();
#define KIN(i) ((const float*)(((const GAS float* const __attribute__((address_space(4)))*)ka)[i]))
#define KOUT ((float*)(((GAS float* const __attribute__((address_space(4)))*)ka)[34]))
    GAS unsigned char* ws = (GAS unsigned char*)args.ws;
    const float* x = KIN(0);
#define XB ((bf16*)(ws + WS_XB))
#define RSTD0 ((float*)(ws + WS_RSTD0))
#define WIN_T ((bf16*)(ws + WS_WIN_T))
#define WOUT_T ((bf16*)(ws + WS_WOUT_T))
#define WCQ_N ((bf16*)(ws + WS_WCQ_N))
#define WCKV_T ((bf16*)(ws + WS_WCKV_T))
#define WCO_T ((bf16*)(ws + WS_WCO_T))
#define MN ((bf16*)(ws + WS_MN))
#define MKV ((bf16*)(ws + WS_MKV))
#define WQK_T ((bf16*)(ws + WS_WQK_T))
#define WVO_T ((bf16*)(ws + WS_WVO_T))
#define WL ((bf16*)(ws + WS_WL))
#define W1_T ((bf16*)(ws + WS_W1_T))
#define W2_T ((bf16*)(ws + WS_W2_T))
#define PROJ ((bf16*)(ws + WS_PROJ))
#define Y ((bf16*)(ws + WS_Y))
#define X1 ((float*)(ws + WS_X1))
#define X1B ((bf16*)(ws + WS_X1B))
#define P ((bf16*)(ws + WS_P))
#define X2 ((float*)(ws + WS_X2))
#define X2B ((bf16*)(ws + WS_X2B))
#define SS1 ((float*)(ws + WS_CTL + CTL_SS1))
#define SS2 ((float*)(ws + WS_CTL + CTL_SS2))
#define CNT ((int*)(ws + WS_CTL + CTL_CNT))
#define GATE ((float*)(ws + WS_GATE))
#define ROWOF ((int*)(ws + WS_ROWOF))
#define TOKOF ((int*)(ws + WS_TOKOF))
#define LIST ((int*)(ws + WS_LIST))
#define WCNT ((int*)(ws + WS_LIST))
#define SELR ((int*)(ws + WS_LIST + MiB))
#define RS2 ((float*)(ws + WS_RS2))
#define RG ((float*)(ws + WS_RG))
#define XG ((bf16*)(ws + WS_XG))
#define ACT ((bf16*)(ws + WS_ACT))
#define YE ((bf16*)(ws + WS_XG))
#define RS ((bf16*)(ws + WS_RS))
#define LWA ((float*)(ws + WS_LW))
#define GG ((bf16*)(ws + WS_GG))
#define OC ((bf16*)(ws + WS_OC))
#define TMP ((float*)(ws + WS_TMP))

    if (IN(0)) {
        refresh(F); asm volatile("" : "+s"(ws), "+s"(ka));
        LAS float* scr = (LAS float*)(F.lds + RING_OFF + F.wave * 16384);
        constexpr int I_IN = (D / 64) * (MIX_IN / 32), I_SQ = (D / 64) * (D / 32), I_KV = (D / 64) * (2 * D / 32), I_W1 = (D / 64) * (2 * FF / 32), I_W2 = (FF / 64) * (D / 32);
        constexpr int NITEMS = I_IN + 2 * I_SQ + I_KV;
        for (int it = F.gw; it < NITEMS; it += F.NGW) {
            int r = it;
            if (r < I_IN) { p0_transpose_item(KIN(3), MIX_IN, D, MIX_IN, KIN(2), WIN_T, scr, r, F.lane, RWKV_IN, RWKV_IN + 512, 0.125f * 1.4426950408889634f); continue; } r -= I_IN;
            if (r < I_SQ) { p0_transpose_item(KIN(20), D, D, D, nullptr, WOUT_T, scr, r, F.lane); continue; } r -= I_SQ;
            if (r < I_SQ) { p0_transpose_item(KIN(25), D, D, D, nullptr, WCO_T, scr, r, F.lane); continue; } r -= I_SQ;
            p0_transpose_item(KIN(24), 2 * D, D, 2 * D, nullptr, WCKV_T, scr, r, F.lane);
        }
        for (int i = F.gt; i < (PROJ_LD - MIX_IN) * D / 8; i += F.NGT) *((v4u*)(WIN_T + (size_t)MIX_IN * D) + i) = (v4u){0u, 0u, 0u, 0u};
        for (int i = F.gt; i < D * D / 4; i += F.NGT) { const int k = i / (D / 4); const f32x4 v = *((const f32x4*)KIN(23) + i); const float g = KIN(21)[k];
            *((v2u*)WCQ_N + i) = (v2u){pk2(v.x * g, v.y * g), pk2(v.z * g, v.w * g)}; }
        for (int i = F.gt; i < C * 288; i += F.NGT) { const int c = i / 288, j = i - c * 288;
            const float v = j < 64 ? KIN(6)[j * C + c] : j < 128 ? KIN(8)[(j - 64) * C + c] : KIN(9)[(j - 128) * C + c]; WL[i] = (bf16)f2bf(v); }
        for (int i = F.gt; i < XROWS; i += F.NGT) TOKOF[i] = 0;
#pragma unroll 2
        for (int m = F.gw; m < T; m += F.NGW) row_to_bf16(F.lane, x + (size_t)m * D, XB + (size_t)m * D, nullptr, false, RSTD0 + m);
        for (int m = F.gw; m < BATCH * MEM; m += F.NGW) row_to_bf16(F.lane, KIN(1) + (size_t)m * D, MN + (size_t)m * D, KIN(22), true, nullptr);
    }
    SEAM(0);
    if (IN(1)) {
        refresh(F); asm volatile("" : "+s"(ws), "+s"(ka));
#if OPT_GEMM
        { pg8::GridSched S{(const char*)XB, (const char*)WIN_T, D, D, T / 256, PROJ_LD / 256, F.G, (int)blockIdx.x, 0, 1 << 30, 0};
          pg8::EpiBf16 E{PROJ, PROJ_LD, RSTD0};
          pg8::gemm_phase<pg8::EpiBf16, pg8::GridSched, true>(F.lds + RING_OFF, F.wave, D, D, D, S, E); }
        { pg8::GridSched S{(const char*)MN, (const char*)WCKV_T, D, D, BATCH * MEM / 256, 2 * D / 256, F.G, (int)blockIdx.x, 128 % F.G, 1 << 30, 0};
          pg8::EpiBf16 E{MKV, 2 * D, nullptr};
          pg8::gemm_phase<pg8::EpiBf16, pg8::GridSched, true>(F.lds + RING_OFF, F.wave, D, D, D, S, E); }
#else
        ref_gemm(F, RefG{XB, D, WIN_T, D, T, PROJ_LD, D}, [&](int row, int col, const float (&a)[4]) { const float s = RSTD0[row];
            *(v2u*)(PROJ + (size_t)row * PROJ_LD + col) = (v2u){pk2(a[0] * s, a[1] * s), pk2(a[2] * s, a[3] * s)}; });
        ref_gemm(F, RefG{MN, D, WCKV_T, D, BATCH * MEM, 2 * D, D}, [&](int row, int col, const float (&a)[4]) {
            *(v2u*)(MKV + (size_t)row * 2 * D + col) = (v2u){pk2(a[0], a[1]), pk2(a[2], a[3])}; });
#endif
    }
    SEAM(1);
    if (IN(2)) {
        refresh(F); asm volatile("" : "+s"(ws), "+s"(ka));
#if OPT_PREP
        {
            typedef float f32x16 __attribute__((ext_vector_type(16)));
            const GAS float* mu = (const GAS float*)KIN(4); const GAS float* w0 = (const GAS float*)KIN(5); const GAS float* a0 = (const GAS float*)KIN(7); const GAS float* k_k = (const GAS float*)KIN(10); const GAS float* k_a = (const GAS float*)KIN(11);
            const long TC = (long)T * C; bf16 *Rr = RS, *Kr = RS + TC, *Vr = RS + 2 * TC, *KKr = RS + 3 * TC, *KKAr = RS + 4 * TC; float* Wr = LWA;
            const rwkv::ChunkBufs cb{(unsigned char*)(ws + WS_GF), (unsigned char*)(ws + WS_HT), (unsigned char*)(ws + WS_RF), (unsigned char*)(ws + WS_Y0)};
            LAS unsigned char* LA = F.lds + RING_OFF; constexpr int LAS_ = 592;
            const int hd = F.wave;
            LAS float* TQ = (LAS float*)(F.lds + RING_OFF + 40960) + F.wave * 1152;
            LAS float* CST = (LAS float*)(F.lds + RING_OFF + 77824);
            for (int i = F.wave * 64 + lane_id(); i < 7 * C; i += NTHR) { const int a = i / C, c = i - a * C;
                CST[i] = a == 0 ? mu[c] : a == 1 ? mu[512 + c] : a == 2 ? mu[1024 + c] : a == 3 ? w0[c] : a == 4 ? a0[c] : a == 5 ? k_k[c] : k_a[c]; }
            for (int tt = F.vcu; tt < T / 64; tt += F.G) { const int t0 = tt * 64;
                {
                    const int ln = lane_id(); float mx = 0.f;
#pragma unroll 2
                    for (int i = 0; i < 8; ++i) { const bf16* pr = PROJ + (size_t)(t0 + F.wave * 8 + i) * PROJ_LD + RWKV_IN + ln * 16; const v4u u0 = *(const v4u*)pr, u1 = *(const v4u*)(pr + 8); float s = 0.f;
#pragma unroll
                        for (int e = 0; e < 4; ++e) { const float a0_ = __uint_as_float(u0[e] << 16), a1_ = __uint_as_float(u0[e] & 0xffff0000u), b0_ = __uint_as_float(u1[e] << 16), b1_ = __uint_as_float(u1[e] & 0xffff0000u); s += a0_ * a0_ + a1_ * a1_ + b0_ * b0_ + b1_ * b1_; }
                        s += __shfl_xor(s, 1); s += __shfl_xor(s, 2); mx = fmaxf(mx, s); }
                    if ((ln & 3) == 0) atomicMax((unsigned*)(F.ctl + CTL_NRM / 4) + (t0 / SEQ) * 16 + (ln >> 2), __float_as_uint(mx)); }
                __syncthreads();
#pragma unroll
                for (int it = 0; it < 5; ++it) { const int idx = it * NTHR + F.wave * 64 + lane_id();
                    if (idx < 64 * 36) { const int t = idx / 36, jg = idx - t * 36, col = 1536 + 8 * jg, row = t0 + t;
                        const v4u y8 = *(const v4u*)(PROJ + (size_t)row * PROJ_LD + col); const v4u p8 = (row % SEQ == 0) ? (v4u){0u, 0u, 0u, 0u} : *(const v4u*)(PROJ + (size_t)(row - 1) * PROJ_LD + col);
                        const f32x4 m0 = *(const GAS f32x4*)(mu + col), m1 = *(const GAS f32x4*)(mu + col + 4); float u[8];
#pragma unroll
                        for (int e = 0; e < 8; ++e) { const float y = __uint_as_float((e & 1) ? (y8[e >> 1] & 0xffff0000u) : (y8[e >> 1] << 16)), yp = __uint_as_float((e & 1) ? (p8[e >> 1] & 0xffff0000u) : (p8[e >> 1] << 16));
                            const float mm = e < 4 ? m0[e & 3] : m1[e & 3]; float v = y + mm * (yp - y);
                            if (jg < 8) v = 1.f - 2.f * __builtin_amdgcn_rcpf(__expf(2.f * v) + 1.f); else if (jg >= 16) v = __builtin_amdgcn_rcpf(1.f + __expf(-v));
                            u[e] = v; }
                        *(LAS v4u*)(LA + t * LAS_ + jg * 16) = (v4u){cvtpk(u[0], u[1]), cvtpk(u[2], u[3]), cvtpk(u[4], u[5]), cvtpk(u[6], u[7])}; } }
                __syncthreads();
#pragma unroll 1
                for (int rt = 0; rt < 2; ++rt) {
                    asm volatile("" : "+s"(mu), "+s"(w0), "+s"(a0), "+s"(k_k), "+s"(k_a));
                    const int r32 = lane_id() & 31, hh = lane_id() >> 5;
                    const int row = t0 + rt * 32 + r32; const bool first = (row % SEQ) == 0; const bf16* p = PROJ + (size_t)row * PROJ_LD; const bf16* pp = first ? p : p - PROJ_LD; const float pm = first ? 0.f : 1.f;
                    float ssq = 0.f;
#pragma unroll
                    for (int ct = 0; ct < 2; ++ct)
#pragma unroll
                        for (int g4 = 0; g4 < 4; ++g4) { const int c = hd * 64 + ct * 32 + 8 * g4 + 4 * hh;
                            const v2u yk = *(const v2u*)(p + 512 + c), pk_ = *(const v2u*)(pp + 512 + c); const f32x4 mk = *(const LAS f32x4*)(CST + 512 + c), kkc = *(const LAS f32x4*)(CST + 5 * 512 + c);
#pragma unroll
                            for (int e = 0; e < 4; ++e) { const float y = __uint_as_float((e & 1) ? (yk[e >> 1] & 0xffff0000u) : (yk[e >> 1] << 16)), yp = pm * __uint_as_float((e & 1) ? (pk_[e >> 1] & 0xffff0000u) : (pk_[e >> 1] << 16));
                                const float kx = y + mk[e] * (yp - y); const float q = kx * kkc[e]; ssq += q * q; } }
                    ssq += __shfl_xor(ssq, 32);
                    const float rn = 1.0f / fmaxf(sqrtf(ssq), 1e-12f);
#pragma unroll
                    for (int ct = 0; ct < 2; ++ct) {
                        f32x16 ad = {}, aa = {}, ag = {};
                        v2u yr[4], pr_[4], yv[4], pv_[4], yk[4], pk_[4];
                        asm volatile("" ::: "memory");
#pragma unroll
                        for (int g4 = 0; g4 < 4; ++g4) { const int c = hd * 64 + ct * 32 + 8 * g4 + 4 * hh;
                            yr[g4] = *(const v2u*)(p + c); pr_[g4] = *(const v2u*)(pp + c); yv[g4] = *(const v2u*)(p + 1024 + c); pv_[g4] = *(const v2u*)(pp + 1024 + c); yk[g4] = *(const v2u*)(p + 512 + c); pk_[g4] = *(const v2u*)(pp + 512 + c); }
                        const GAS bf16* wl0 = (const GAS bf16*)(WL + (size_t)(hd * 64 + ct * 32 + r32) * 288 + 8 * hh); asm volatile("" : "+v"(wl0));
#pragma unroll
                        for (int s = 0; s < 18; ++s) { const bf16x8 fb = *(const LAS bf16x8*)(LA + (rt * 32 + r32) * LAS_ + (16 * s + 8 * hh) * 2); const bf16x8 fa = *(const GAS bf16x8*)(wl0 + 16 * s);
                            if (s < 4) ad = __builtin_amdgcn_mfma_f32_32x32x16_bf16(fa, fb, ad, 0, 0, 0);
                            else if (s < 8) aa = __builtin_amdgcn_mfma_f32_32x32x16_bf16(fa, fb, aa, 0, 0, 0);
                            else ag = __builtin_amdgcn_mfma_f32_32x32x16_bf16(fa, fb, ag, 0, 0, 0); }
                        f32x4 ov[6][4];
#pragma unroll
                        for (int g4 = 0; g4 < 4; ++g4) { const int c = hd * 64 + ct * 32 + 8 * g4 + 4 * hh;
                            const f32x4 mr = *(const LAS f32x4*)(CST + c), mk = *(const LAS f32x4*)(CST + 512 + c), mv = *(const LAS f32x4*)(CST + 1024 + c), w0c = *(const LAS f32x4*)(CST + 3 * 512 + c), a0c = *(const LAS f32x4*)(CST + 4 * 512 + c), kkc = *(const LAS f32x4*)(CST + 5 * 512 + c), kac = *(const LAS f32x4*)(CST + 6 * 512 + c);
#pragma unroll
                            for (int e = 0; e < 4; ++e) { const int r = 4 * g4 + e;
                                const float y1 = __uint_as_float((e & 1) ? (yr[g4][e >> 1] & 0xffff0000u) : (yr[g4][e >> 1] << 16)), p1 = pm * __uint_as_float((e & 1) ? (pr_[g4][e >> 1] & 0xffff0000u) : (pr_[g4][e >> 1] << 16));
                                const float y3 = __uint_as_float((e & 1) ? (yv[g4][e >> 1] & 0xffff0000u) : (yv[g4][e >> 1] << 16)), p3 = pm * __uint_as_float((e & 1) ? (pv_[g4][e >> 1] & 0xffff0000u) : (pv_[g4][e >> 1] << 16));
                                const float y2 = __uint_as_float((e & 1) ? (yk[g4][e >> 1] & 0xffff0000u) : (yk[g4][e >> 1] << 16)), p2 = pm * __uint_as_float((e & 1) ? (pk_[g4][e >> 1] & 0xffff0000u) : (pk_[g4][e >> 1] << 16));
                                const float kx = y2 + mk[e] * (p2 - y2);
                                const float dw = w0c[e] + ad[r]; const float zz = -dw; const float sp = fmaxf(zz, 0.f) + __logf(1.f + __expf(-fabsf(zz)));
                                const float av = __builtin_amdgcn_rcpf(1.f + __expf(-(a0c[e] + aa[r]))); const float kk = kx * kkc[e] * rn;
                                ov[0][g4][e] = y1 + mr[e] * (p1 - y1); ov[1][g4][e] = -__expf(-sp - 0.5f); ov[2][g4][e] = kx * (1.f + (av - 1.f) * kac[e]); ov[3][g4][e] = y3 + mv[e] * (p3 - y3); ov[4][g4][e] = kk; ov[5][g4][e] = kk * av; } }
                        { const int ln = lane_id(); const size_t rb = (size_t)(t0 + rt * 32) * C + hd * 64 + ct * 32;
#pragma unroll
                          for (int a = 0; a < 7; ++a) {
#pragma unroll
                              for (int g4 = 0; g4 < 4; ++g4) *(LAS f32x4*)(TQ + r32 * 36 + 8 * g4 + 4 * hh) = (a < 6) ? ov[a < 6 ? a : 0][g4] : (f32x4){ag[4 * g4], ag[4 * g4 + 1], ag[4 * g4 + 2], ag[4 * g4 + 3]};
                              LDS_WAIT(); asm volatile("" ::: "memory");
                              if (a == 1) {
#pragma unroll
                                  for (int i = 0; i < 4; ++i) { const int tr = (ln >> 3) + 8 * i, cq = (ln & 7) * 4; *(f32x4*)(Wr + rb + (size_t)tr * C + cq) = *(const LAS f32x4*)(TQ + tr * 36 + cq); } }
                              else { bf16* dstp = a == 0 ? Rr : a == 2 ? Kr : a == 3 ? Vr : a == 4 ? KKr : a == 5 ? KKAr : GG;
#pragma unroll
                                  for (int i = 0; i < 2; ++i) { const int tr = (ln >> 2) + 16 * i, cq = (ln & 3) * 8; const f32x4 v0 = *(const LAS f32x4*)(TQ + tr * 36 + cq), v1 = *(const LAS f32x4*)(TQ + tr * 36 + cq + 4);
                                      *(v4u*)(dstp + rb + (size_t)tr * C + cq) = (v4u){cvtpk(v0[0], v0[1]), cvtpk(v0[2], v0[3]), cvtpk(v1[0], v1[1]), cvtpk(v1[2], v1[3])}; } }
                              LDS_WAIT(); asm volatile("" ::: "memory"); } }
                    }
                }
                __syncthreads();
                { const int b = t0 / SEQ, c0 = (t0 % SEQ) / rwkv::L;
#pragma unroll 1
                  for (int rt = 0; rt < 2; ++rt) rwkv::stage1_chunk(F.lds + RING_OFF + F.wave * rwkv::WAVE_LDS, cb, (b * NH + hd) * rwkv::NCH + c0 + rt, Rr, Wr, Kr, Vr, KKr, KKAr, lane_id()); }
            }
        }
#else
        {
            LAS float* su = (LAS float*)(F.lds); LAS float* ssq = su + 2048;
            const float* mu = KIN(4); const float* w0 = KIN(5); const float* Wd = KIN(6); const float* a0 = KIN(7); const float* Wa = KIN(8); const float* Wg = KIN(9);
            const float* k_k = KIN(10); const float* k_a = KIN(11);
            const long TC = (long)T * C; float *Rr = RS, *Wr = RS + TC, *Kr = RS + 2 * TC, *Vr = RS + 3 * TC, *KKr = RS + 4 * TC, *KKAr = RS + 5 * TC;
            const int c = F.tid;
            for (int t = F.vcu; t < T; t += F.G) {
                const bool first = (t % SEQ) == 0; const bf16* p = PROJ + (size_t)t * PROJ_LD; const bf16* pp = p - PROJ_LD;
                __syncthreads();
                for (int j = c; j < RWKV_IN; j += NTHR) { const float y = bf2f(p[j]), yp = first ? 0.f : bf2f(pp[j]); float u = y + mu[j] * (yp - y);
                    if (j >= 1536 && j < 1600) u = tanhf(u); else if (j >= 1664) u = 1.f / (1.f + expf(-u));
                    su[j] = u; }
                __syncthreads();
                float dw = w0[c], da = a0[c], dg = 0.f;
#pragma unroll 4
                for (int i = 0; i < 64; ++i) { dw += su[1536 + i] * Wd[i * C + c]; da += su[1600 + i] * Wa[i * C + c]; }
#pragma unroll 4
                for (int i = 0; i < 160; ++i) dg += su[1664 + i] * Wg[i * C + c];
                const float zz = -dw; const float sp = fmaxf(zz, 0.f) + log1pf(expf(-fabsf(zz)));
                const float decay = -expf(-sp - 0.5f)  ; const float aa = 1.f / (1.f + expf(-da));
                const float r = su[c], k = su[512 + c], v = su[1024 + c];
                const float kkv = k * k_k[c]; ssq[c] = kkv * kkv; __syncthreads();
                float s2 = 0.f; const int h0 = c & ~63;
#pragma unroll 8
                for (int i = 0; i < 64; ++i) s2 += ssq[h0 + i];
                const float kk = kkv / fmaxf(sqrtf(s2), 1e-12f); const float k2 = k * (1.f + (aa - 1.f) * k_a[c]);
                const long o = (long)t * C + c;
                Rr[o] = r; Wr[o] = decay; Kr[o] = k2; Vr[o] = v; KKr[o] = kk; KKAr[o] = kk * aa; GG[o] = dg;
            }
        }
#endif
    }
    SEAM(2);
    if (IN(3)) {
        refresh(F); asm volatile("" : "+s"(ws), "+s"(ka));
#if OPT_GEMM
        { pg8::FoldSched S{(const char*)MKV, (const char*)WCQ_N, 0, F.G, (int)blockIdx.x, 128 % F.G}; pg8::EpiBf16 E{WQK_T, D, nullptr};
          pg8::gemm_phase<pg8::EpiBf16, pg8::FoldSched, true>(F.lds + RING_OFF, F.wave, 256, 2 * D, D, S, E); }
        { pg8::FoldSched S{(const char*)MKV, (const char*)WCO_T, 1, F.G, (int)blockIdx.x, 192 % F.G}; pg8::EpiBf16 E{WVO_T, D, nullptr};
          pg8::gemm_phase<pg8::EpiBf16, pg8::FoldSched, true>(F.lds + RING_OFF, F.wave, 256, D, 2 * D, S, E); }
        __syncthreads();
#else
        for (int z = 0; z < BATCH * 4; ++z) { const int b = z >> 2, h = z & 3;
            ref_gemm(F, RefG{MKV + (size_t)b * MEM * 2 * D + h * 256, 2 * D, WCQ_N + h * 256, D, MEM, D, 256}, [&](int row, int col, const float (&a)[4]) {
                *(v2u*)(WQK_T + ((size_t)b * D + h * 256 + row) * D + col) = (v2u){pk2(a[0], a[1]), pk2(a[2], a[3])}; });
            ref_gemm(F, RefG{WCO_T + h * 256, D, MKV + (size_t)b * MEM * 2 * D + D + h * 256, 2 * D, D, MEM, 256}, [&](int row, int col, const float (&a)[4]) {
                *(v2u*)(WVO_T + ((size_t)b * D + row) * D + h * 256 + col) = (v2u){pk2(a[0], a[1]), pk2(a[2], a[3])}; });
        }
#endif
#if OPT_ATTN
        {
            const int ng = (F.G % 8 == 0) ? 8 : 1, gsz = F.G / ng, xg = F.vcu / gsz, wl = F.vcu - xg * gsz;
            const int nsl = 32 / ng;
            if (wl < nsl) { const int sid = (xg * nsl + wl) * 2 + F.wave;
                if (F.wave < 2) { const rwkv::ChunkBufs cb{(unsigned char*)(ws + WS_GF), (unsigned char*)(ws + WS_HT), (unsigned char*)(ws + WS_RF), (unsigned char*)(ws + WS_Y0)};
                    rwkv::stage2(cb, sid >> 1, sid & 1, (float*)(ws + WS_YRAW), lane_id()); }
                __syncthreads(); }
            else if (wl < nsl + (CONV_EIGHTHS * gsz) / 8) {
                constexpr int I_W1 = (D / 64) * (2 * FF / 32), I_W2 = (FF / 64) * (D / 32), NMOE = NE * (I_W1 + I_W2);
                LAS float* scr = (LAS float*)(F.lds + RING_OFF + F.wave * 16384); gu32* CQ = F.ctl + CTL_Q / 4 + 8 * 64;
                for (;;) {
                    if (F.wave == 0 && lane_id() == 0) F.MISC[16] = __hip_atomic_fetch_add(CQ, 64u, RLX_AGENT);
                    __syncthreads(); const int base = (int)F.MISC[16]; __syncthreads();
                    if (base >= NMOE) break;
#pragma unroll 1
                    for (int i = 0; i < 8; i += 4) {
                        TItem ti[4]; bool ok[4];
#pragma unroll
                        for (int u = 0; u < 4; ++u) { int r = base + F.wave * 8 + i + u; ok[u] = r < NMOE; if (!ok[u]) r = NMOE - 1;
                            const int e = r / (I_W1 + I_W2); r -= e * (I_W1 + I_W2); const bool w1 = r < I_W1; const int it = w1 ? r : r - I_W1; const int N = w1 ? 2 * FF : D, nblk = N / 32;
                            ti[u].W = (const GAS float*)(w1 ? KIN(29) + (size_t)e * D * 2 * FF : KIN(31) + (size_t)e * FF * D); ti[u].WT = (GAS bf16*)(w1 ? W1_T + (size_t)e * 2 * FF * D : W2_T + (size_t)e * D * FF);
                            ti[u].rowg = (const GAS float*)(w1 ? KIN(26) : nullptr); ti[u].ldw = N; ti[u].K = D; ti[u].k0 = 64 * (it / nblk); ti[u].n0 = 32 * (it % nblk); }
                        f32x4 va[8], vb[8], vc[8], vd[8]; float ga[8], gb[8], gc[8], gd[8]; const int ln = lane_id();
                        p0_t_load(ti[0], va, ga, ln); p0_t_load(ti[1], vb, gb, ln); p0_t_load(ti[2], vc, gc, ln); p0_t_load(ti[3], vd, gd, ln);
                        if (ok[0]) p0_t_finish(ti[0], va, ga, scr, ln);
                        if (ok[1]) p0_t_finish(ti[1], vb, gb, scr, ln);
                        if (ok[2]) p0_t_finish(ti[2], vc, gc, scr, ln);
                        if (ok[3]) p0_t_finish(ti[3], vd, gd, scr, ln); }
                }
                __syncthreads(); }
            const int upq = 512 / ng;
            for (int gi = 0; gi < ng; ++gi) { const int qg = (xg + gi) % ng; gu32* Q = F.ctl + CTL_Q / 4 + qg * 64;
            for (;;) {
                if (F.wave == 0 && lane_id() == 0) F.MISC[16] = __hip_atomic_fetch_add(Q, 1u, RLX_AGENT);
                __syncthreads(); const int idx = (int)F.MISC[16]; __syncthreads();
                if (idx >= upq) break;
                const int qb = 15 - idx / (upq / 16), hc = qg * (32 / ng) + idx % (upq / 16);
                const int b = hc >> 3, h = (hc >> 1) & 3, cm = hc & 1;
                const bf16* pb = PROJ + (size_t)b * SEQ * PROJ_LD + RWKV_IN + h * 128;
                int tstart = 0;
                {
                    const unsigned* nr = (const unsigned*)(F.ctl + CTL_NRM / 4) + b * 16; const float q2 = __uint_as_float(__hip_atomic_load(nr + h * 2 + cm, RLX_AGENT)), k2 = __uint_as_float(__hip_atomic_load(nr + 8 + h * 2 + cm, RLX_AGENT));
                    const float xmax = sqrtf(q2 * k2) * 1.01f + 2.f, beta_ = exp2f(-2.0f * (h + 1)) * 1.4426950408889634f;
                    const float lim = (float)(qb * 256 - 63) - (xmax + 152.f) / beta_;
                    if (ATTN_SKIP && lim > 0.f) { tstart = ((int)(lim * (1.f / 64.f))) & ~1; const int ntall = 4 * qb + 4; if (tstart > ntall - 4) tstart = ntall - 4; if (tstart < 0) tstart = 0; } }
                attn_body::attn_unit<8>(F.wave, qb, tstart, pb + cm * 64, pb + 512 + cm * 64, pb + 1024, OC + ((size_t)cm * T + (size_t)b * SEQ) * C + h * 128, exp2f(-2.0f * (h + 1)) * 1.4426950408889634f, (char*)lds + RING_OFF);
            } }
        }
#else
        for (int u = F.vcu; u < BATCH * 8 * (SEQ / NTHR); u += F.G) {
            const int qb = u % (SEQ / NTHR), hc = (u / (SEQ / NTHR)) % 8, b = u / (8 * (SEQ / NTHR)); const int h = hc >> 1, cm = hc & 1;
            const int q = qb * NTHR + F.tid; const float slope = exp2f(-2.0f * (h + 1)) * 1.4426950408889634f;
            const bf16* base = PROJ + (size_t)b * SEQ * PROJ_LD + RWKV_IN; const bf16* qp = base + (size_t)q * PROJ_LD + h * 128 + cm * 64;
            float qr[64];
#pragma unroll
            for (int d = 0; d < 64; ++d) qr[d] = bf2f(qp[d]);
            float o[128];
#pragma unroll
            for (int e = 0; e < 128; ++e) o[e] = 0.f;
            float m = -INFINITY, l = 0.f; const int jmax = qb * NTHR + NTHR - 1;
            for (int j = 0; j <= jmax; ++j) {
                const bf16* kp = base + (size_t)j * PROJ_LD + 512 + h * 128 + cm * 64; const bf16* vp = base + (size_t)j * PROJ_LD + 1024 + h * 128;
                if (j <= q) {
                    float sc = 0.f;
#pragma unroll
                    for (int d = 0; d < 64; ++d) sc += qr[d] * bf2f(kp[d]);
                    sc -= slope * (float)(q - j);
                    if (sc > m) { const float f = exp2f(m - sc); l *= f;
#pragma unroll
                        for (int e = 0; e < 128; ++e) o[e] *= f;
                        m = sc; }
                    const float pr = exp2f(sc - m); l += pr;
#pragma unroll
                    for (int e = 0; e < 128; ++e) o[e] += pr * bf2f(vp[e]);
                }
            }
            const float il = 1.f / l; bf16* op = OC + ((size_t)cm * T + (size_t)b * SEQ + q) * C + h * 128;
#pragma unroll
            for (int e = 0; e < 128; ++e) op[e] = (bf16)f2bf(o[e] * il);
        }
#endif
    }
    SEAM(3);
    if (IN(5)) {
        refresh(F); asm volatile("" : "+s"(ws), "+s"(ka));
        const float s1 = wave_sum(KIN(15)[F.lane] * KIN(16)[F.lane]), s2 = wave_sum(KIN(17)[F.lane] * KIN(18)[F.lane]);
        const float lam = expf(s1) - expf(s2) + 0.2f; const float* sg = KIN(19);
        {
            const long TC = (long)T * C; const bf16 *Rr = RS, *Kr = RS + TC, *Vr = RS + 2 * TC; const float* YRAW = (const float*)(ws + WS_YRAW);
            const int c0 = F.lane * 8;
            f32x4 lg[2], lb[2], rk[2], sgv[2];
#pragma unroll
            for (int q = 0; q < 2; ++q) { lg[q] = *(const f32x4*)(KIN(13) + c0 + 4 * q); lb[q] = *(const f32x4*)(KIN(14) + c0 + 4 * q); rk[q] = *(const f32x4*)(KIN(12) + c0 + 4 * q); sgv[q] = *(const f32x4*)(sg + (c0 & 127) + 4 * q); }
#pragma unroll 2
            for (int t = F.gw; t < T; t += F.NGW) { const size_t o = (size_t)t * C + c0;
                f32x4 y[2], r[2], kx[2], vv[2], g[2];
#pragma unroll
                for (int q = 0; q < 2; ++q) y[q] = *(const f32x4*)(YRAW + o + 4 * q);
                { const v4u ur = *(const v4u*)(Rr + o), uk = *(const v4u*)(Kr + o), uv = *(const v4u*)(Vr + o), ug = *(const v4u*)(GG + o);
#pragma unroll
                  for (int e = 0; e < 4; ++e) { r[e >> 1][2 * (e & 1)] = __uint_as_float(ur[e] << 16); r[e >> 1][2 * (e & 1) + 1] = __uint_as_float(ur[e] & 0xffff0000u); kx[e >> 1][2 * (e & 1)] = __uint_as_float(uk[e] << 16); kx[e >> 1][2 * (e & 1) + 1] = __uint_as_float(uk[e] & 0xffff0000u);
                      vv[e >> 1][2 * (e & 1)] = __uint_as_float(uv[e] << 16); vv[e >> 1][2 * (e & 1) + 1] = __uint_as_float(uv[e] & 0xffff0000u); g[e >> 1][2 * (e & 1)] = __uint_as_float(ug[e] << 16); g[e >> 1][2 * (e & 1) + 1] = __uint_as_float(ug[e] & 0xffff0000u); } }
                const v4u a0 = *(const v4u*)(OC + (size_t)t * C + c0), a1 = *(const v4u*)(OC + ((size_t)T + t) * C + c0);
                float s = 0.f, bsum = 0.f;
#pragma unroll
                for (int q = 0; q < 2; ++q) { s += (y[q].x + y[q].y) + (y[q].z + y[q].w); const f32x4 pr = r[q] * kx[q] * rk[q]; bsum += (pr.x + pr.y) + (pr.z + pr.w); }
                s += __shfl_xor(s, 1); s += __shfl_xor(s, 2); s += __shfl_xor(s, 4); bsum += __shfl_xor(bsum, 1); bsum += __shfl_xor(bsum, 2); bsum += __shfl_xor(bsum, 4);
                const float mu_ = s * (1.f / 64.f); float var = 0.f;
#pragma unroll
                for (int q = 0; q < 2; ++q) { const f32x4 d = y[q] - mu_; var += (d.x * d.x + d.y * d.y) + (d.z * d.z + d.w * d.w); }
                var += __shfl_xor(var, 1); var += __shfl_xor(var, 2); var += __shfl_xor(var, 4);
                const float rstd = 1.0f / sqrtf(var * (1.f / 64.f) + GN_EPS);
                v4u w;
#pragma unroll
                for (int q = 0; q < 2; ++q) { const f32x4 o4 = (((y[q] - mu_) * rstd) * lg[q] + lb[q] + vv[q] * bsum) * g[q]; w[2 * q] = pk2(o4.x, o4.y); w[2 * q + 1] = pk2(o4.z, o4.w); }
                *(v4u*)(Y + (size_t)t * D + c0) = w;
                float d8[8]; float ssd = 0.f;
#pragma unroll
                for (int e = 0; e < 4; ++e) { d8[2 * e] = __uint_as_float(a0[e] << 16) - lam * __uint_as_float(a1[e] << 16); d8[2 * e + 1] = __uint_as_float(a0[e] & 0xffff0000u) - lam * __uint_as_float(a1[e] & 0xffff0000u); ssd += d8[2 * e] * d8[2 * e] + d8[2 * e + 1] * d8[2 * e + 1]; }
                ssd += __shfl_xor(ssd, 1); ssd += __shfl_xor(ssd, 2); ssd += __shfl_xor(ssd, 4); ssd += __shfl_xor(ssd, 8);
                const float rsd = 0.8f / sqrtf(ssd * (1.f / 128.f) + NORM_EPS);
                v4u wd; wd.x = pk2(d8[0] * rsd * sgv[0].x, d8[1] * rsd * sgv[0].y); wd.y = pk2(d8[2] * rsd * sgv[0].z, d8[3] * rsd * sgv[0].w); wd.z = pk2(d8[4] * rsd * sgv[1].x, d8[5] * rsd * sgv[1].y); wd.w = pk2(d8[6] * rsd * sgv[1].z, d8[7] * rsd * sgv[1].w);
                *(v4u*)(Y + (size_t)t * D + C + c0) = wd;
            }
        }
    }
    SEAM(5);
    if (IN(6)) {
        refresh(F); asm volatile("" : "+s"(ws), "+s"(ka));
#if OPT_GEMM
        pg8::GridSched S{(const char*)Y, (const char*)WOUT_T, D, D, T / 256, D / 256, F.G, (int)blockIdx.x, 0, 1 << 30, 0};
        pg8::EpiResid E{x, nullptr, nullptr, X1B, SS1};
        pg8::gemm_phase<pg8::EpiResid, pg8::GridSched, true>(F.lds + RING_OFF, F.wave, D, D, D, S, E);
#else
        ref_gemm(F, RefG{Y, D, WOUT_T, D, T, D, D}, [&](int row, int col, const float (&a)[4]) { float q = 0.f;
            for (int j = 0; j < 4; ++j) { const float v = x[(size_t)row * D + col + j] + a[j]; X1[(size_t)row * D + col + j] = v; X1B[(size_t)row * D + col + j] = (bf16)f2bf(v); q += v * v; }
            atomicAdd(SS1 + row, q); });
#endif
    }
    SEAM(6);
    if (IN(7)) {
        refresh(F); asm volatile("" : "+s"(ws), "+s"(ka));
#if OPT_GEMM
        pg8::GridSched S{(const char*)X1B, (const char*)WQK_T, D, D, T / 256, D / 256, F.G, (int)blockIdx.x, 0, SEQ, (size_t)D * D * 2};
        pg8::EpiSoftmax E{P, SS1, 1.4426950408889634f / 16.f, (LAS float*)(F.lds + EPIX_OFF)};
        pg8::gemm_phase<pg8::EpiSoftmax, pg8::GridSched, true>(F.lds + RING_OFF, F.wave, D, D, D, S, E);
#else
        for (int b = 0; b < BATCH; ++b)
            ref_gemm(F, RefG{X1B + (size_t)b * SEQ * D, D, WQK_T + (size_t)b * D * D, D, SEQ, D, D}, [&](int row, int col, const float (&a)[4]) { const int grow = b * SEQ + row;
                const float s = (1.0f / sqrtf(SS1[grow] * (1.f / D) + NORM_EPS)) * (1.4426950408889634f / 16.f);
                for (int j = 0; j < 4; ++j) TMP[(size_t)grow * D + col + j] = a[j] * s; });
#endif
    }
    SEAM(7);
    if (IN(8) && !OPT_GEMM) {
        refresh(F); asm volatile("" : "+s"(ws), "+s"(ka));
        for (int seg = F.gw; seg < T * 4; seg += F.NGW) { const float* p = TMP + (size_t)seg * 256; float v[4]; float m = -INFINITY;
            for (int i = 0; i < 4; ++i) { v[i] = p[F.lane + 64 * i]; m = fmaxf(m, v[i]); }
            for (int q = 1; q < 64; q <<= 1) m = fmaxf(m, __shfl_xor(m, q));
            float l = 0.f; for (int i = 0; i < 4; ++i) { v[i] = exp2f(v[i] - m); l += v[i]; }
            l = wave_sum(l); const float il = 1.f / l;
            for (int i = 0; i < 4; ++i) P[(size_t)seg * 256 + F.lane + 64 * i] = (bf16)f2bf(v[i] * il); }
    }
#if !OPT_GEMM
    SEAM(8);
#endif
    if (IN(9)) {
        refresh(F); asm volatile("" : "+s"(ws), "+s"(ka));
#if OPT_GEMM
        pg8::GridSched S{(const char*)P, (const char*)WVO_T, D, D, T / 256, D / 256, F.G, (int)blockIdx.x, 0, SEQ, (size_t)D * D * 2};
        pg8::EpiResid E{nullptr, X1B, X2, X2B, SS2};
        pg8::gemm_phase<pg8::EpiResid, pg8::GridSched, true>(F.lds + RING_OFF, F.wave, D, D, D, S, E);
#else
        for (int b = 0; b < BATCH; ++b)
            ref_gemm(F, RefG{P + (size_t)b * SEQ * D, D, WVO_T + (size_t)b * D * D, D, SEQ, D, D}, [&](int row, int col, const float (&a)[4]) { const int grow = b * SEQ + row; float q = 0.f;
                for (int j = 0; j < 4; ++j) { const float v = X1[(size_t)grow * D + col + j] + a[j]; X2[(size_t)grow * D + col + j] = v; X2B[(size_t)grow * D + col + j] = (bf16)f2bf(v); q += v * v; }
                atomicAdd(SS2 + grow, q); });
#endif
    }
    SEAM(9);
    if (IN(10)) {
        refresh(F); asm volatile("" : "+s"(ws), "+s"(ka));
#if OPT_ROUTER
        {
            typedef float f32x16 __attribute__((ext_vector_type(16)));
            const float* wr = KIN(27); const float* br = KIN(28); const float* gf = KIN(26);
            const int tp = F.wave >> 2, q = F.wave & 3, e = F.lane & 31, kh = F.lane >> 5;
            float wreg[128];
#pragma unroll
            for (int i = 0; i < 128; ++i) { const int kk = 256 * q + 8 * (i >> 2) + 4 * kh + (i & 3); wreg[i] = wr[kk * NE + e] * gf[kk]; }
            LAS float* PT = (LAS float*)(F.lds + RING_OFF); LAS float* LT = (LAS float*)(F.lds + RING_OFF + 32768); LAS int* WC = (LAS int*)(F.lds + RING_OFF + 49152);
            for (int pair = F.vcu; pair < T / 64; pair += F.G) {
                const int t0 = pair * 64 + tp * 32;
                const float* xrow = X2 + (size_t)(t0 + e) * D + 256 * q + 4 * kh;
                f32x16 acc = {};
#pragma unroll
                for (int blk = 0; blk < 32; ++blk) { if ((blk & 7) == 0) asm volatile("" ::: "memory");
                    const f32x4 xa = *(const f32x4*)(xrow + 8 * blk);
#pragma unroll
                    for (int j = 0; j < 4; ++j) acc = __builtin_amdgcn_mfma_f32_32x32x2f32(xa[j], wreg[4 * blk + j], acc, 0, 0, 0); }
                __syncthreads();
                if (F.tid < NE) WC[F.tid] = 0;
#pragma unroll
                for (int r = 0; r < 16; ++r) PT[((tp * 4 + q) * 64 + F.lane) * 16 + r] = acc[r];
                __syncthreads();
                if (q == 0) {
#pragma unroll
                    for (int r = 0; r < 16; ++r) { float sacc = 0.f;
#pragma unroll
                        for (int qq = 0; qq < 4; ++qq) sacc += PT[((tp * 4 + qq) * 64 + F.lane) * 16 + r];
                        LT[(tp * 32 + ((r & 3) + 8 * (r >> 2) + 4 * kh)) * 33 + e] = sacc; }
                    asm volatile("s_waitcnt lgkmcnt(0)" ::: "memory");
                    if (F.lane < 32) { const int t = t0 + F.lane; float lg[NE];
                        const float rs = 1.0f / sqrtf(SS2[t] * (1.f / D) + NORM_EPS);
#pragma unroll
                        for (int ee = 0; ee < NE; ++ee) lg[ee] = LT[(tp * 32 + F.lane) * 33 + ee] * rs + br[ee];
                        int sel[4]; float val[4];
#pragma unroll
                        for (int s = 0; s < 4; ++s) { float best = -INFINITY; int bi = 0;
#pragma unroll
                            for (int ee = 0; ee < NE; ++ee) { const bool ok = lg[ee] > best; best = ok ? lg[ee] : best; bi = ok ? ee : bi; }
                            sel[s] = bi; val[s] = best;
#pragma unroll
                            for (int ee = 0; ee < NE; ++ee) if (ee == bi) lg[ee] = -INFINITY; }
                        float sum = 0.f, pe[4];
#pragma unroll
                        for (int s = 0; s < 4; ++s) { pe[s] = expf(val[s] - val[0]); sum += pe[s]; }
#pragma unroll
                        for (int s = 0; s < 4; ++s) { const int slot = t * 4 + s; GATE[slot] = pe[s] / sum;
                            const int rank = __hip_atomic_fetch_add(WC + sel[s], 1, __ATOMIC_RELAXED, __HIP_MEMORY_SCOPE_WORKGROUP);
                            SELR[slot] = sel[s] | (rank << 8); }
                    }
                }
                __syncthreads();
                if (F.tid < NE) WCNT[pair * NE + F.tid] = WC[F.tid];
            }
        }
#else
        const float* wr = KIN(27); const float* br = KIN(28); const float* gf = KIN(26);
        for (int t = F.gt; t < T; t += F.NGT) {
            float lg[NE];
#pragma unroll
            for (int e = 0; e < NE; ++e) lg[e] = 0.f;
            const float* hr = X2 + (size_t)t * D;
            for (int k = 0; k < D; ++k) { const float hv = hr[k] * gf[k];
#pragma unroll
                for (int e = 0; e < NE; ++e) lg[e] += hv * wr[k * NE + e]; }
            const float rs = 1.0f / sqrtf(SS2[t] * (1.f / D) + NORM_EPS);
#pragma unroll
            for (int e = 0; e < NE; ++e) lg[e] = lg[e] * rs + br[e];
            int sel[4]; float val[4];
#pragma unroll
            for (int s = 0; s < 4; ++s) { float best = -INFINITY; int bi = 0;
#pragma unroll
                for (int e = 0; e < NE; ++e) { const bool ok = lg[e] > best; best = ok ? lg[e] : best; bi = ok ? e : bi; }
                sel[s] = bi; val[s] = best;
#pragma unroll
                for (int e = 0; e < NE; ++e) if (e == bi) lg[e] = -INFINITY; }
            float sum = 0.f, pe[4];
#pragma unroll
            for (int s = 0; s < 4; ++s) { pe[s] = expf(val[s] - val[0]); sum += pe[s]; }
#pragma unroll
            for (int s = 0; s < 4; ++s) { const int slot = t * 4 + s; GATE[slot] = pe[s] / sum; const int pos = atomicAdd(&CNT[sel[s]], 1); LIST[(size_t)sel[s] * T + pos] = slot; }
        }
#endif
    }
    SEAM(10);
    if (IN(11)) {
        refresh(F); asm volatile("" : "+s"(ws), "+s"(ka));
#if OPT_ROUTER
        {
            LAS int* SB = (LAS int*)(F.lds + RING_OFF);
            for (int pair = F.vcu; pair < T / 64; pair += F.G) {
                __syncthreads();
                { const int e = F.lane & 31, p0 = (F.wave * 2 + (F.lane >> 5)) * 16; int sa = 0, sb = 0;
#pragma unroll 4
                  for (int p = p0; p < p0 + 16; ++p) { const int v = WCNT[p * NE + e]; sa += v; sb += (p < pair) ? v : 0; }
                  sa += __shfl_xor(sa, 32); sb += __shfl_xor(sb, 32);
                  if (F.lane < 32) { SB[F.wave * 32 + e] = sa; SB[256 + F.wave * 32 + e] = sb; } }
                __syncthreads();
                if (F.wave == 0) { const int e = F.lane & 31; int tot = 0, wo = 0;
#pragma unroll
                    for (int w = 0; w < 8; ++w) { tot += SB[w * 32 + e]; wo += SB[256 + w * 32 + e]; }
                    const int pad = (tot + 255) & ~255; int incl = pad;
#pragma unroll
                    for (int o = 1; o < 32; o <<= 1) { const int v = __shfl_up(incl, o, 32); if (e >= o) incl += v; }
                    if (F.lane < 32) { SB[512 + e] = incl - pad + wo; if (pair == 0) CNT[e] = tot; } }
                __syncthreads();
                if (F.lane < 32) { const int slot = pair * 256 + F.wave * 32 + F.lane, tok = slot >> 2; const int sr = SELR[slot]; const int row = SB[512 + (sr & 255)] + (sr >> 8);
                    TOKOF[row] = tok; ROWOF[slot] = row; RS2[row] = 1.0f / sqrtf(SS2[tok] * (1.f / D) + NORM_EPS); RG[row] = GATE[slot]; }
            }
        }
#else
        for (int e = 0; e < NE; ++e) { const int base = __shfl(ebase_l, e), cnt = __shfl(ecnt_l, e);
            for (int i = F.gw; i < cnt; i += F.NGW) { const int slot = LIST[(size_t)e * T + i], tok = slot >> 2, row = base + i;
                const v4u* src = (const v4u*)(X2B + (size_t)tok * D); v4u* dst = (v4u*)(XG + (size_t)row * D);
                dst[F.lane] = src[F.lane]; dst[F.lane + 64] = src[F.lane + 64];
                if (F.lane == 0) { ROWOF[slot] = row; RS2[row] = 1.0f / sqrtf(SS2[tok] * (1.f / D) + NORM_EPS); RG[row] = GATE[slot]; } } }
#endif
    }
    SEAM(11);
    if (IN(12) || IN(13)) {
        refresh(F); asm volatile("" : "+s"(ws), "+s"(ka));
        const int e = F.lane & 31; const int ecnt = __hip_atomic_load((const int*)CNT + e, RLX_AGENT); const int pad = (ecnt + 255) & ~255; int incl = pad;
#pragma unroll
        for (int o = 1; o < 32; o <<= 1) { const int v = __shfl_up(incl, o, 32); if (e >= o) incl += v; }
        if (F.wave == 0 && F.lane < 32) { F.MISC[32 + e] = (unsigned)(incl - pad); F.MISC[64 + e] = (unsigned)ecnt;
            if (e == 31) { const int total = incl / 256, G = F.G;
                const int T0 = (MOE_SPLIT && G % 8 == 0) ? ((total * 8 / G) * (G / 8) < total ? (total * 8 / G) * (G / 8) : total) : total, rem1 = (total - T0) * 8;
                int TE = rem1 > 0 ? (G - rem1) / 4 : 0; TE = TE < T0 ? TE : T0;
                F.MISC[96] = (unsigned)total; F.MISC[97] = (unsigned)T0; F.MISC[98] = (unsigned)rem1; F.MISC[99] = (unsigned)TE; } }
        __syncthreads();
    }
    if (IN(12)) {
        refresh(F); asm volatile("" : "+s"(ws), "+s"(ka));
#if OPT_GEMM
        {
            if (F.tid == 0) { F.MISC[102] = 0u; F.MISC[103] = F.MISC[97]; } __syncthreads();
            pg8::MoeSched S{(const char*)X2B, (const char*)W1_T, TOKOF, D, D, 2 * FF / 256, F.G, (int)blockIdx.x, F.MISC + 32, (size_t)2 * FF * D * 2};
            pg8::EpiMoe1 E{ACT, RS2, KIN(30)};
            pg8::gemm_phase<pg8::EpiMoe1, pg8::MoeSched, true, true>(F.lds + RING_OFF, F.wave, D, D, D, S, E); }
        const int rem1 = __builtin_amdgcn_readfirstlane((int)F.MISC[98]);
        if (rem1 > 0) {
            refresh(F); asm volatile("" : "+s"(ws), "+s"(ka));
            split_arrive((unsigned*)(F.ctl + CTL_RDY / 4), F.wave);
            if ((int)blockIdx.x < rem1) {
                if (F.tid == 0) { F.MISC[102] = F.MISC[97]; F.MISC[103] = F.MISC[96]; } __syncthreads();
                pg8::MoeSched S{(const char*)X2B, (const char*)W1_T, TOKOF, D, D, 2 * FF / 256, rem1, (int)blockIdx.x, F.MISC + 32, (size_t)2 * FF * D * 2};
                pg8::EpiMoe1 E{ACT, RS2, KIN(30)};
                pg8::gemm_phase<pg8::EpiMoe1, pg8::MoeSched, true, true>(F.lds + RING_OFF, F.wave, D, D, D, S, E);
            } else {
                split_wait((unsigned*)(F.ctl + CTL_RDY / 4), (unsigned)F.G, bar.bar, F.wave);
                if (F.tid == 0) { F.MISC[102] = 0u; F.MISC[103] = F.MISC[99]; } __syncthreads();
                pg8::MoeSched S{(const char*)ACT, (const char*)W2_T, nullptr, FF, FF, D / 256, F.G - rem1, (int)blockIdx.x - rem1, F.MISC + 32, (size_t)D * FF * 2};
                pg8::EpiMoe2 E{YE, RG, KIN(32)};
                pg8::gemm_phase<pg8::EpiMoe2, pg8::MoeSched, true>(F.lds + RING_OFF, F.wave, FF, FF, FF, S, E);
            }
        }
#else
        for (int e = 0; e < NE; ++e) { const int base = __shfl(ebase_l, e), cnt = __shfl(ecnt_l, e);
            ref_gemm(F, RefG{XG + (size_t)base * D, D, W1_T + (size_t)e * 2 * FF * D, D, cnt, 2 * FF, D}, [&](int row, int col, const float (&a)[4]) { const int grow = base + row; const float s = RS2[grow];
                const float* bb = KIN(30) + (size_t)e * 2 * FF + col;
                ACT[(size_t)grow * FF + (col >> 1)] = (bf16)f2bf(swiglu_f(a[0] * s + bb[0], a[1] * s + bb[1])); ACT[(size_t)grow * FF + (col >> 1) + 1] = (bf16)f2bf(swiglu_f(a[2] * s + bb[2], a[3] * s + bb[3])); }); }
#endif
    }
    SEAM(12);
    if (IN(13)) {
        refresh(F); asm volatile("" : "+s"(ws), "+s"(ka));
#if OPT_GEMM
        if (F.tid == 0) { F.MISC[102] = F.MISC[99]; F.MISC[103] = F.MISC[96]; } __syncthreads();
        pg8::MoeSched S{(const char*)ACT, (const char*)W2_T, nullptr, FF, FF, D / 256, F.G, (int)blockIdx.x, F.MISC + 32, (size_t)D * FF * 2};
        pg8::EpiMoe2 E{YE, RG, KIN(32)};
        pg8::gemm_phase<pg8::EpiMoe2, pg8::MoeSched, true>(F.lds + RING_OFF, F.wave, FF, FF, FF, S, E);
#else
        for (int e = 0; e < NE; ++e) { const int base = __shfl(ebase_l, e), cnt = __shfl(ecnt_l, e);
            ref_gemm(F, RefG{ACT + (size_t)base * FF, FF, W2_T + (size_t)e * D * FF, FF, cnt, D, FF}, [&](int row, int col, const float (&a)[4]) { const int grow = base + row; const float s = RG[grow];
                const float* bb = KIN(32) + (size_t)e * D + col;
                *(v2u*)(YE + (size_t)grow * D + col) = (v2u){pk2((a[0] + bb[0]) * s, (a[1] + bb[1]) * s), pk2((a[2] + bb[2]) * s, (a[3] + bb[3]) * s)}; }); }
#endif
    }
    SEAM(13);
    if (IN(14)) {
        refresh(F); asm volatile("" : "+s"(ws), "+s"(ka));
        const float* gfin = KIN(33);
        for (int t = F.gw; t < T; t += F.NGW) {
            int ro[4];
#pragma unroll
            for (int kq = 0; kq < 4; ++kq) ro[kq] = ROWOF[t * 4 + kq];
            const int c0 = F.lane * 16; f32x4 v[4];
#pragma unroll
            for (int q = 0; q < 4; ++q) v[q] = *(const f32x4*)(X2 + (size_t)t * D + c0 + 4 * q);
#pragma unroll
            for (int kq = 0; kq < 4; ++kq) { const v4u a = *(const v4u*)(YE + (size_t)ro[kq] * D + c0), b = *(const v4u*)(YE + (size_t)ro[kq] * D + c0 + 8);
#pragma unroll
                for (int e = 0; e < 4; ++e) { v[e >> 1][2 * (e & 1)] += __uint_as_float(a[e] << 16); v[e >> 1][2 * (e & 1) + 1] += __uint_as_float(a[e] & 0xffff0000u);
                                              v[2 + (e >> 1)][2 * (e & 1)] += __uint_as_float(b[e] << 16); v[2 + (e >> 1)][2 * (e & 1) + 1] += __uint_as_float(b[e] & 0xffff0000u); } }
            float ss = 0.f;
#pragma unroll
            for (int q = 0; q < 4; ++q) ss += (v[q].x * v[q].x + v[q].y * v[q].y) + (v[q].z * v[q].z + v[q].w * v[q].w);
            const float rs = 1.0f / sqrtf(wave_sum(ss) * (1.f / D) + NORM_EPS);
#pragma unroll
            for (int q = 0; q < 4; ++q) { const f32x4 g = *(const f32x4*)(gfin + c0 + 4 * q); *(f32x4*)(KOUT + (size_t)t * D + c0 + 4 * q) = v[q] * rs * g; }
        }
    }
#if PROBE_LATE_P1
    xcd_barrier(bar, F.wave);
    {
        refresh(F); asm volatile("" : "+s"(ws), "+s"(ka));
        { pg8::GridSched S{(const char*)XB, (const char*)WIN_T, D, D, T / 256, PROJ_LD / 256, F.G, (int)blockIdx.x, 0, 1 << 30, 0};
          pg8::EpiBf16 E{PROJ, PROJ_LD, RSTD0};
          pg8::gemm_phase<pg8::EpiBf16, pg8::GridSched, true>(F.lds + RING_OFF, F.wave, D, D, D, S, E); }
    }
#endif
#undef XB
#undef RSTD0
#undef WIN_T
#undef WOUT_T
#undef WCQ_N
#undef WCKV_T
#undef WCO_T
#undef MN
#undef MKV
#undef WQK_T
#undef WVO_T
#undef WL
#undef W1_T
#undef W2_T
#undef PROJ
#undef Y
#undef X1
#undef X1B
#undef P
#undef X2
#undef X2B
#undef SS1
#undef SS2
#undef CNT
#undef GATE
#undef ROWOF
#undef TOKOF
#undef LIST
#undef WCNT
#undef SELR
#undef RS2
#undef RG
#undef XG
#undef ACT
#undef YE
#undef RS
#undef GG
#undef LWA
#undef OC
#undef TMP
#undef KIN
#undef KOUT
#undef IN
#undef SEAM
}

constexpr int N_PHASES = 15;
#ifndef MK_N_LAUNCHES
#define MK_N_LAUNCHES 1
#endif
extern "C" void kernel_launch(void* const* d_in, const int* in_sizes, int n_in, void* d_out, int out_size, void* d_ws, size_t ws_size, hipStream_t stream) {
    static int grid = 0;
    if (grid == 0) {
        int dev = 0, cus = 0, per_cu = 0;
        if (n_in != 34 || out_size != T * D || ws_size < WS_END) { fprintf(stderr, "kernel_launch: unexpected problem shape (n_in %d out %d ws %zu)\n", n_in, out_size, ws_size); grid = -1; return; }
        if (hipGetDevice(&dev) != hipSuccess || hipDeviceGetAttribute(&cus, hipDeviceAttributeMultiprocessorCount, dev) != hipSuccess) { grid = -1; return; }
        if (hipFuncSetAttribute((const void*)mk_fwd, hipFuncAttributeMaxDynamicSharedMemorySize, LDS_BYTES) != hipSuccess) { fprintf(stderr, "kernel_launch: hipFuncSetAttribute failed\n"); grid = -1; return; }
        if (hipOccupancyMaxActiveBlocksPerMultiprocessor(&per_cu, (const void*)mk_fwd, NTHR, LDS_BYTES) != hipSuccess || per_cu < 1) { fprintf(stderr, "kernel_launch: occupancy query says %d\n", per_cu); per_cu = 1; }
        (void)hipGetLastError();
        grid = cus;
    }
    if (grid < 0) return;
    (void)hipMemsetAsync((char*)d_ws + WS_CTL, 0, CTL_ZERO_BYTES, stream);
    Args a{};
    for (int i = 0; i < 34; ++i) a.in[i] = (const float*)d_in[i];
    a.out = (float*)d_out; a.ws = (unsigned char*)d_ws;
#ifndef MK_LAST_PHASE
#define MK_LAST_PHASE N_PHASES
#endif
    if (MK_REPEAT_PHASE >= 0) {
        a.ph_lo = 0; a.ph_hi = MK_REPEAT_PHASE + 1; a.li = 0; hipLaunchKernelGGL(mk_fwd, dim3(grid), dim3(NTHR), LDS_BYTES, stream, a);
        a.ph_lo = MK_REPEAT_PHASE; a.ph_hi = N_PHASES; a.li = 1; hipLaunchKernelGGL(mk_fwd, dim3(grid), dim3(NTHR), LDS_BYTES, stream, a); }
    else if (MK_N_LAUNCHES == 1) { a.ph_lo = 0; a.ph_hi = MK_LAST_PHASE; hipLaunchKernelGGL(mk_fwd, dim3(grid), dim3(NTHR), LDS_BYTES, stream, a); }
    else for (int p = 0; p < N_PHASES; ++p) { a.ph_lo = p; a.ph_hi = p + 1; a.li = p; hipLaunchKernelGGL(mk_fwd, dim3(grid), dim3(NTHR), LDS_BYTES, stream, a); }
}
```
